# Optimizing an MI355X kernel written in HIP

```python
import math
import jax, jax.numpy as jnp
from jax import lax
import numpy as np

D_MODEL = 2048
BATCH = 2
SEQ = 8192
DEPTH = 1

CHUNK = 64
Q_BLOCK = 128
MLA_HEADS = 8
MLA_NOPE_DIM = 128
MLA_ROPE_DIM = 64
MLA_V_DIM = 128
MLA_Q_RANK = 384
MLA_KV_RANK = 256
ROPE_THETA = 10000.0
DIFF_HEADS = 8
DIFF_HEAD_DIM = 64
DIFF_V_DIM = 2 * DIFF_HEAD_DIM
REL_BUCKETS = 32
REL_MAX_DIST = 128
N_EXPERTS = 32
TOP_K = 4
D_FF = 2048
SWIGLU_LIMIT = 7.0
SWIGLU_ALPHA = 1.702
MOE_BLOCK = 256
EPS = 1e-6

IN_SPLITS = (MLA_Q_RANK, MLA_KV_RANK, MLA_ROPE_DIM,
             DIFF_HEADS * 2 * DIFF_HEAD_DIM, DIFF_HEADS * 2 * DIFF_HEAD_DIM, DIFF_HEADS * DIFF_V_DIM)
IN_WIDTH = sum(IN_SPLITS)
SPLIT_POINTS = tuple(int(v) for v in np.cumsum(IN_SPLITS)[:-1])
MIX_WIDTH = MLA_HEADS * MLA_V_DIM + DIFF_HEADS * DIFF_V_DIM

kernel_name = "hybrid_mla_diffattn_moe_block"


def rms_norm(x, w):
    xf = x.astype(jnp.float32)
    y = xf * lax.rsqrt(jnp.mean(xf * xf, axis=-1, keepdims=True) + EPS)
    return (y * w.astype(jnp.float32)).astype(x.dtype)


def rope_tables(pos):
    inv_freq = ROPE_THETA ** (-jnp.arange(0, MLA_ROPE_DIM, 2, dtype=jnp.float32) / MLA_ROPE_DIM)
    ang = pos.astype(jnp.float32)[:, None] * inv_freq[None, :]
    return jnp.cos(ang), jnp.sin(ang)


def apply_rope(x, cos, sin):
    half = x.shape[-1] // 2
    x1, x2 = x[..., :half], x[..., half:]
    c = cos[None, :, None, :].astype(x.dtype)
    s = sin[None, :, None, :].astype(x.dtype)
    return jnp.concatenate([x1 * c - x2 * s, x2 * c + x1 * s], axis=-1)


def chunk_mask(qpos, kpos):
    return (kpos[None, :] // CHUNK) <= (qpos[:, None] // CHUNK)


def t5_bucket(rel):
    nb = REL_BUCKETS // 2
    max_exact = nb // 2
    ret = jnp.where(rel > 0, nb, 0)
    n = jnp.abs(rel)
    nf = jnp.maximum(n, 1).astype(jnp.float32)
    large = max_exact + (jnp.log(nf / max_exact) / math.log(REL_MAX_DIST / max_exact)
                         * (nb - max_exact)).astype(jnp.int32)
    large = jnp.minimum(large, nb - 1)
    return ret + jnp.where(n < max_exact, n, large)


def to_blocks(t):
    b, h, s = t.shape[:3]
    t = t.reshape((b, h, s // Q_BLOCK, Q_BLOCK) + t.shape[3:])
    return jnp.moveaxis(t, 2, 0)


def from_blocks(o):
    nb, b, h, qb, dv = o.shape
    return o.transpose(1, 0, 3, 2, 4).reshape(b, nb * qb, h * dv)


def mla_mixer(c_q, c_kv, k_rope_raw, pos, cos, sin,
              q_a_norm_w, w_uq, kv_a_norm_w, w_ukv, q_norm_w, k_norm_w):
    B, S, _ = c_q.shape
    qk_dim = MLA_NOPE_DIM + MLA_ROPE_DIM
    q = (rms_norm(c_q, q_a_norm_w) @ w_uq).reshape(B, S, MLA_HEADS, qk_dim)
    kv = (rms_norm(c_kv, kv_a_norm_w) @ w_ukv).reshape(B, S, MLA_HEADS, MLA_NOPE_DIM + MLA_V_DIM)
    k_nope, v = kv[..., :MLA_NOPE_DIM], kv[..., MLA_NOPE_DIM:]
    k_shared = jnp.broadcast_to(k_rope_raw[:, :, None, :], (B, S, MLA_HEADS, MLA_ROPE_DIM))
    k = jnp.concatenate([k_nope, k_shared], axis=-1)
    q = rms_norm(q, q_norm_w)
    k = rms_norm(k, k_norm_w)
    q = jnp.concatenate([q[..., :MLA_NOPE_DIM], apply_rope(q[..., MLA_NOPE_DIM:], cos, sin)], axis=-1)
    k = jnp.concatenate([k[..., :MLA_NOPE_DIM], apply_rope(k[..., MLA_NOPE_DIM:], cos, sin)], axis=-1)
    scale = qk_dim ** -0.5
    qb = to_blocks(q.transpose(0, 2, 1, 3))
    k = k.transpose(0, 2, 1, 3)
    v = v.transpose(0, 2, 1, 3)

    def body(args):
        qblk, qp = args
        s = jnp.einsum('bhqd,bhkd->bhqk', qblk, k).astype(jnp.float32) * scale
        s = jnp.where(chunk_mask(qp, pos)[None, None], s, -jnp.inf)
        p = jax.nn.softmax(s, axis=-1).astype(v.dtype)
        return jnp.einsum('bhqk,bhkd->bhqd', p, v)

    o = lax.map(body, (qb, pos.reshape(-1, Q_BLOCK)))
    return from_blocks(o)


def diff_mixer(q_raw, k_raw, v_raw, pos, rel_bias, q_norm_w, k_norm_w,
               lambda_q1, lambda_k1, lambda_q2, lambda_k2, subln_w, lambda_init):
    B, S, _ = q_raw.shape
    q = rms_norm(q_raw.reshape(B, S, DIFF_HEADS, 2, DIFF_HEAD_DIM), q_norm_w).transpose(0, 2, 1, 3, 4)
    k = rms_norm(k_raw.reshape(B, S, DIFF_HEADS, 2, DIFF_HEAD_DIM), k_norm_w).transpose(0, 2, 1, 3, 4)
    v = v_raw.reshape(B, S, DIFF_HEADS, DIFF_V_DIM).transpose(0, 2, 1, 3)
    lam = (jnp.exp(jnp.sum(lambda_q1.astype(jnp.float32) * lambda_k1.astype(jnp.float32)))
           - jnp.exp(jnp.sum(lambda_q2.astype(jnp.float32) * lambda_k2.astype(jnp.float32)))
           + lambda_init)
    scale = DIFF_HEAD_DIM ** -0.5
    qb = to_blocks(q)

    def body(args):
        qblk, qp = args
        s = jnp.einsum('bhqcd,bhkcd->cbhqk', qblk, k).astype(jnp.float32) * scale
        bias = rel_bias[t5_bucket(pos[None, :] - qp[:, None])]
        s = s + bias.transpose(2, 0, 1)[None, None].astype(jnp.float32)
        s = jnp.where(chunk_mask(qp, pos)[None, None, None], s, -jnp.inf)
        p = jax.nn.softmax(s, axis=-1)
        a = (p[0] - lam * p[1]).astype(v.dtype)
        return jnp.einsum('bhqk,bhkd->bhqd', a, v)

    o = lax.map(body, (qb, pos.reshape(-1, Q_BLOCK)))
    o = rms_norm(o, subln_w) * (1.0 - lambda_init)
    return from_blocks(o)


def moe_ffn(h, router_w, router_b, w_gate_up, b_gate_up, w_down, b_down):
    T, D = h.shape
    logits = (h @ router_w + router_b).astype(jnp.float32)
    top_logits, top_idx = lax.top_k(logits, TOP_K)
    gates = jax.nn.softmax(top_logits, axis=-1)
    tk = T * TOP_K
    flat_e = top_idx.reshape(tk)
    order = jnp.argsort(flat_e)
    sorted_e = flat_e[order]
    sorted_tok = order // TOP_K
    sorted_gate = gates.reshape(tk)[order]
    counts = jnp.bincount(flat_e, length=N_EXPERTS)
    starts = jnp.cumsum(counts) - counts
    padded = (counts + MOE_BLOCK - 1) // MOE_BLOCK * MOE_BLOCK
    pad_ends = jnp.cumsum(padded)
    pad_starts = pad_ends - padded
    dest = pad_starts[sorted_e] + (jnp.arange(tk) - starts[sorted_e])
    n_blocks = -(-tk // MOE_BLOCK) + N_EXPERTS
    slot_tok = jnp.zeros((n_blocks * MOE_BLOCK,), jnp.int32).at[dest].set(sorted_tok.astype(jnp.int32))
    block_e = jnp.minimum(jnp.searchsorted(pad_ends, jnp.arange(n_blocks) * MOE_BLOCK, side='right'),
                          N_EXPERTS - 1)

    def expert_block(args):
        toks, e = args
        xb = h[toks]
        gu = xb @ w_gate_up[e] + b_gate_up[e]
        g = jnp.minimum(gu[:, ::2], SWIGLU_LIMIT)
        u = jnp.clip(gu[:, 1::2], -SWIGLU_LIMIT, SWIGLU_LIMIT)
        a = g * jax.nn.sigmoid(SWIGLU_ALPHA * g) * (u + 1.0)
        return a @ w_down[e] + b_down[e]

    ys = lax.map(expert_block, (slot_tok.reshape(n_blocks, MOE_BLOCK), block_e))
    ys = ys.reshape(n_blocks * MOE_BLOCK, D)
    y_assign = ys[dest] * sorted_gate[:, None].astype(ys.dtype)
    return jax.ops.segment_sum(y_assign, sorted_tok, num_segments=T)


def setup_inputs(seed: int = 0) -> dict:
    key = jax.random.key(seed)
    ks = jax.random.split(key, 26)
    f32 = jnp.float32

    def nrm(k, shape, scale):
        return jax.random.normal(k, shape, f32) * scale

    def gain(k, shape):
        return 1.0 + 0.02 * jax.random.normal(k, shape, f32)

    L = DEPTH
    return {
        "x": jax.random.normal(ks[0], (BATCH, SEQ, D_MODEL), f32),
        "attn_norm_w": gain(ks[1], (L, D_MODEL)),
        "w_in": nrm(ks[2], (L, D_MODEL, IN_WIDTH), D_MODEL ** -0.5),
        "q_a_norm_w": gain(ks[3], (L, MLA_Q_RANK)),
        "w_uq": nrm(ks[4], (L, MLA_Q_RANK, MLA_HEADS * (MLA_NOPE_DIM + MLA_ROPE_DIM)), MLA_Q_RANK ** -0.5),
        "kv_a_norm_w": gain(ks[5], (L, MLA_KV_RANK)),
        "w_ukv": nrm(ks[6], (L, MLA_KV_RANK, MLA_HEADS * (MLA_NOPE_DIM + MLA_V_DIM)), MLA_KV_RANK ** -0.5),
        "mla_q_norm_w": gain(ks[7], (L, MLA_NOPE_DIM + MLA_ROPE_DIM)),
        "mla_k_norm_w": gain(ks[8], (L, MLA_NOPE_DIM + MLA_ROPE_DIM)),
        "diff_q_norm_w": gain(ks[9], (L, DIFF_HEAD_DIM)),
        "diff_k_norm_w": gain(ks[10], (L, DIFF_HEAD_DIM)),
        "lambda_q1": nrm(ks[11], (L, DIFF_HEAD_DIM), 0.1),
        "lambda_k1": nrm(ks[12], (L, DIFF_HEAD_DIM), 0.1),
        "lambda_q2": nrm(ks[13], (L, DIFF_HEAD_DIM), 0.1),
        "lambda_k2": nrm(ks[14], (L, DIFF_HEAD_DIM), 0.1),
        "diff_subln_w": gain(ks[15], (L, DIFF_V_DIM)),
        "w_o": nrm(ks[16], (L, MIX_WIDTH, D_MODEL), MIX_WIDTH ** -0.5),
        "ffn_norm_w": gain(ks[17], (L, D_MODEL)),
        "router_w": nrm(ks[18], (L, D_MODEL, N_EXPERTS), D_MODEL ** -0.5),
        "router_b": nrm(ks[19], (L, N_EXPERTS), 0.01),
        "w_gate_up": nrm(ks[20], (L, N_EXPERTS, D_MODEL, 2 * D_FF), D_MODEL ** -0.5),
        "b_gate_up": nrm(ks[21], (L, N_EXPERTS, 2 * D_FF), 0.02),
        "w_down": nrm(ks[22], (L, N_EXPERTS, D_FF, D_MODEL), D_FF ** -0.5),
        "b_down": nrm(ks[23], (L, N_EXPERTS, D_MODEL), 0.02),
        "rel_bias": nrm(ks[24], (REL_BUCKETS, DIFF_HEADS), 0.5),
    }


def reference(x, attn_norm_w, w_in, q_a_norm_w, w_uq, kv_a_norm_w, w_ukv, mla_q_norm_w, mla_k_norm_w,
              diff_q_norm_w, diff_k_norm_w, lambda_q1, lambda_k1, lambda_q2, lambda_k2, diff_subln_w,
              w_o, ffn_norm_w, router_w, router_b, w_gate_up, b_gate_up, w_down, b_down, rel_bias):
    B, S, D = x.shape
    pos = jnp.arange(S, dtype=jnp.int32)
    cos, sin = rope_tables(pos)
    for l in range(DEPTH):
        lambda_init = 0.8 - 0.6 * math.exp(-0.3 * l)
        h = rms_norm(x, attn_norm_w[l])
        proj = h @ w_in[l]
        c_q, c_kv, k_rope_raw, dq, dk, dv = jnp.split(proj, SPLIT_POINTS, axis=-1)
        y_mla = mla_mixer(c_q, c_kv, k_rope_raw, pos, cos, sin,
                          q_a_norm_w[l], w_uq[l], kv_a_norm_w[l], w_ukv[l],
                          mla_q_norm_w[l], mla_k_norm_w[l])
        y_diff = diff_mixer(dq, dk, dv, pos, rel_bias, diff_q_norm_w[l], diff_k_norm_w[l],
                            lambda_q1[l], lambda_k1[l], lambda_q2[l], lambda_k2[l],
                            diff_subln_w[l], lambda_init)
        x = x + jnp.concatenate([y_mla, y_diff], axis=-1) @ w_o[l]
        h = rms_norm(x, ffn_norm_w[l]).reshape(B * S, D)
        x = x + moe_ffn(h, router_w[l], router_b[l], w_gate_up[l], b_gate_up[l],
                        w_down[l], b_down[l]).reshape(B, S, D)
    return x
```

```cpp
#include <hip/hip_runtime.h>
#include <cstdio>
#include <cstdint>

#define GAS __attribute__((address_space(1)))
#define LAS __attribute__((address_space(3)))
typedef unsigned short bf16;
typedef unsigned v4u __attribute__((ext_vector_type(4)));
typedef unsigned v2u __attribute__((ext_vector_type(2)));
typedef float f32x4 __attribute__((ext_vector_type(4)));
typedef float f32x2 __attribute__((ext_vector_type(2)));
typedef float f32x16 __attribute__((ext_vector_type(16)));
typedef short bf16x8 __attribute__((ext_vector_type(8)));
typedef short s16x4 __attribute__((ext_vector_type(4)));
#define LDS_WAIT() asm volatile("s_waitcnt lgkmcnt(0)" ::: "memory")
#define VM_WAIT() asm volatile("s_waitcnt vmcnt(0)" ::: "memory")

constexpr int NB = 2, SEQ = 8192, DM = 2048, NTOK = NB * SEQ;
constexpr int INW = 3776, INWP = 3840;
constexpr int C_CQ = 0, C_CKV = 384, C_KR = 640, C_DQ = 704, C_DK = 1728, C_DV = 2752;
constexpr int QRANK = 384, KVRANK = 256, MH = 8, QKD = 192, NOPE = 128, ROPE = 64, VD = 128;
constexpr int DH = 8, DHD = 64;
constexpr int NE = 32, TOPK = 4, DFF = 2048, NASG = NTOK * TOPK, NSLOT_MAX = NASG + NE * 256, NBLK_MAX = NSLOT_MAX / 256;
#ifndef X1_BF16
#define X1_BF16 1
#endif
#ifndef X1_COPY
#define X1_COPY 0
#endif
constexpr float EPS = 1e-6f;
constexpr float LOG2E = 1.4426950408889634f;

constexpr size_t MiB = 1u << 20;
constexpr size_t WS_CTL = 0, CTL_ZERO_BYTES = 1 * MiB;
constexpr size_t WS_WIN = 1 * MiB;
constexpr size_t WS_WUQ = WS_WIN + 15 * MiB;
constexpr size_t WS_WUKV = WS_WUQ + 2 * MiB;
constexpr size_t WS_WO = WS_WUKV + 1 * MiB;
constexpr size_t WS_RW = WS_WO + 8 * MiB;
constexpr size_t WS_WGU = WS_RW + 1 * MiB;
constexpr size_t WS_WDN = WS_WGU + 512 * MiB;
constexpr size_t WS_H = WS_WDN + 256 * MiB;
constexpr size_t WS_PROJ = WS_H + 64 * MiB;
constexpr size_t WS_AQ = WS_PROJ + 120 * MiB;
constexpr size_t WS_AKV = WS_AQ + 12 * MiB;
constexpr size_t WS_DQN = WS_AKV + 8 * MiB;
constexpr size_t WS_DKN = WS_DQN + 32 * MiB;
constexpr size_t WS_QF = WS_DKN + 32 * MiB;
constexpr size_t WS_KVF = WS_QF + 48 * MiB;
constexpr size_t WS_QM = WS_KVF + 64 * MiB;
constexpr size_t WS_KM = WS_QM + 48 * MiB;
constexpr size_t WS_OD = WS_KM + 48 * MiB;
constexpr size_t WS_Y = WS_OD + 128 * MiB;
constexpr size_t WS_H2 = WS_Y + 64 * MiB;
constexpr size_t WS_ASG = WS_H2 + 64 * MiB;
constexpr size_t WS_XG = WS_ASG + 1 * MiB;
constexpr size_t WS_ACT = WS_XG + 288 * MiB;
constexpr size_t WS_YS = WS_ACT + 288 * MiB;
constexpr size_t WS_STOK = WS_YS + 288 * MiB;
constexpr size_t WS_UCNT = WS_STOK + 1 * MiB;
constexpr size_t WS_END = WS_UCNT + 1 * MiB;
constexpr int CW_BAR = 4096;
constexpr int CW_CNT = 16384, CW_CNT_STRIDE = 64;
constexpr int CW_AQ = 8192 + 64;
constexpr int CW_AQ_STRIDE = 64;
constexpr int CW_CONV = 8192 + 64 * 32;

constexpr int RING_OFF = 0, RING_BYTES = 131072;
constexpr int MISC_OFF = RING_BYTES;
constexpr int MISC_BAR = MISC_OFF;
constexpr int MISC_UNIT = MISC_OFF + 64;
constexpr int MISC_PADS = MISC_OFF + 256;
constexpr int MISC_CNTS = MISC_OFF + 512;
constexpr int MISC_BLKE = MISC_OFF + 1024;
constexpr int MISC_ITAB = MISC_OFF + 4096;
constexpr int LDS_BYTES = 147456;

__device__ __forceinline__ unsigned f2bf(float f) { unsigned u = __builtin_bit_cast(unsigned, f); return (u + 0x7fffu + ((u >> 16) & 1u)) >> 16; }
__device__ __forceinline__ unsigned pk2(float lo, float hi) { return f2bf(lo) | (f2bf(hi) << 16); }
__device__ __forceinline__ float bflo(unsigned w) { return __builtin_bit_cast(float, w << 16); }
__device__ __forceinline__ float bfhi(unsigned w) { return __builtin_bit_cast(float, w & 0xffff0000u); }
#ifndef WT_STORES
#define WT_STORES 1
#endif
__device__ __forceinline__ void st16_wt(void* p, v4u v) {
#if WT_STORES
    asm volatile("global_store_dwordx4 %0, %1, off sc0 sc1\n\ts_nop 1" :: "v"(p), "v"(v));
#else
    *(v4u*)p = v;
#endif
}
__device__ __forceinline__ float wave_max(float v) {
#pragma unroll
    for (int o = 1; o < 64; o <<= 1) v = fmaxf(v, __shfl_xor(v, o));
    return v;
}
__device__ __forceinline__ float wave_sum(float v) {
#pragma unroll
    for (int o = 1; o < 64; o <<= 1) v += __shfl_xor(v, o);
    return v;
}

#define XB_TMO      128
#define XB_XCNT(j)  (256  + 64 * (j))
#define XB_XSUB(j)  (1280 + 64 * (j))
#define XB_XGEN(j)  (2304 + 64 * (j))
#define XB_TOP      3328
#define XB_TOPGEN   3392
#define XCD_BAR_WORDS 3456
#define XB_SPIN_CAP (1u << 18)

__device__ __forceinline__ unsigned xb_ld(unsigned* p)              { return __hip_atomic_load(p, __ATOMIC_RELAXED, __HIP_MEMORY_SCOPE_AGENT); }
__device__ __forceinline__ unsigned xb_add(unsigned* p, unsigned v) { return __hip_atomic_fetch_add(p, v, __ATOMIC_RELAXED, __HIP_MEMORY_SCOPE_AGENT); }
__device__ __forceinline__ unsigned xb_xcc_id() { return (unsigned)__builtin_amdgcn_s_getreg((3 << 11) | 20) & 0xFu; }
#define XB_SPIN(cond, bar) do { unsigned _sp = 0; while (cond) { __builtin_amdgcn_s_sleep(1); \
    if ((++_sp & 255u) == 0u) { if (xb_ld(&(bar)[XB_TMO])) break; if (_sp > XB_SPIN_CAP) { atomicAdd(&(bar)[XB_TMO], 1u); break; } } } } while (0)

struct XcdBarrier {
    unsigned* bar; unsigned x;
    volatile LAS unsigned* st;
};

__device__ __forceinline__ XcdBarrier xcd_barrier_post(unsigned* bar, volatile LAS unsigned* st) {
    XcdBarrier b; b.bar = bar; b.x = xb_xcc_id(); b.st = st;
    if (threadIdx.x == 0) (void)xb_add(&bar[XB_XCNT(b.x)], 1u);
    return b;
}
__device__ __forceinline__ void xcd_barrier_complete(unsigned* bar, unsigned x, unsigned& nloc, unsigned& nx) {
    const unsigned G = gridDim.x * gridDim.y * gridDim.z;
    unsigned sum, cnt, mine, sp = 0u;
    for (;;) {
        sum = 0u; cnt = 0u; mine = 0u;
#pragma unroll
        for (unsigned j = 0; j < 16; ++j) { const unsigned c = xb_ld(&bar[XB_XCNT(j)]); sum += c; cnt += (c > 0u) ? 1u : 0u; mine = (j == x) ? c : mine; }
        if (sum == G) break;
        __builtin_amdgcn_s_sleep(1);
        if ((++sp & 255u) == 0u) { if (xb_ld(&bar[XB_TMO])) break; if (sp > XB_SPIN_CAP) { atomicAdd(&bar[XB_TMO], 1u); break; } }
    }
    nloc = mine > 0u ? mine : 1u; nx = cnt > 0u ? cnt : 1u;
}

__device__ __forceinline__ void xcd_barrier(const XcdBarrier& b) {
    asm volatile("s_waitcnt vmcnt(0)" ::: "memory");
    __syncthreads();
    if (threadIdx.x == 0) {
        unsigned* bar = b.bar;
        __builtin_amdgcn_s_waitcnt(0);
        unsigned nloc = b.st[0], nx = b.st[1];
        if (nloc == 0u) { xcd_barrier_complete(bar, b.x, nloc, nx); b.st[0] = nloc; b.st[1] = nx; }
        const unsigned old = xb_add(&bar[XB_XSUB(b.x)], 1u);
        const unsigned gen = old / nloc;
        if (old + 1u == (gen + 1u) * nloc) {
            __builtin_amdgcn_fence(__ATOMIC_RELEASE, "agent");
            asm volatile("s_waitcnt vmcnt(0)" ::: "memory");
            const unsigned og = xb_add(&bar[XB_TOP], 1u);
            const unsigned tg = og / nx;
            if (og + 1u == (tg + 1u) * nx) xb_add(&bar[XB_TOPGEN], 1u);
            else XB_SPIN(xb_ld(&bar[XB_TOPGEN]) == tg, bar);
            __builtin_amdgcn_fence(__ATOMIC_ACQUIRE, "agent");
            xb_add(&bar[XB_XGEN(b.x)], 1u);
            asm volatile("s_waitcnt vmcnt(0)" ::: "memory");
        } else {
            XB_SPIN(xb_ld(&bar[XB_XGEN(b.x)]) == gen, bar);
            __builtin_amdgcn_fence(__ATOMIC_ACQUIRE, "agent");
            asm volatile("s_waitcnt vmcnt(0)" ::: "memory");
        }
    }
    __syncthreads();
}

#ifndef PG8_LATE_ISSUE
#define PG8_LATE_ISSUE 0
#endif
namespace pg8 {
typedef int v4i __attribute__((ext_vector_type(4)));
typedef int v8i __attribute__((ext_vector_type(8)));
constexpr int BM = 256, BK = 64, HALF = 128, HTB = HALF * BK * 2  , STAGE_BYTES = 8 * HTB, NXCD = 8, WGM = 8;

__host__ __device__ __forceinline__ int lds_byte(int r, int c) { const int st = (r >> 4) * 2 + (c >> 5), rr = r & 15, cc = c & 31, ob = rr * 64 + cc * 2; return st * 1024 + (ob ^ (((ob >> 9) & 1) << 5)); }
__host__ __device__ __forceinline__ void stage_rc(int b, int& R, int& C) { const int st = b / 1024, sb = b % 1024, swz = sb ^ (((sb >> 9) & 1) << 5); R = (st >> 1) * 16 + swz / 64; C = (st & 1) * 32 + (swz % 64) / 2; }
__host__ __device__ __forceinline__ int perm32(int rho) { const int n = rho >> 4, i = rho & 15; return 8 * (i >> 2) + 4 * n + (i & 3); }

struct Unit { int pm, pn, e; };
struct Gemm { const void* A; const void* Bt; int rowbytes; size_t bstride_e; const int* rowidx; LAS int* idxtab; };
struct GemmDoc_ { int unused_; };

struct StaticOrder {
    int nM, nN, nwg, G, c;
    __device__ void init(int M, int N, int G_, int c_) { nM = M / BM; nN = N / BM; nwg = nM * nN; G = G_; c = c_; }
    __device__ bool next(int i, Unit& u) const {
        const long L = (long)i * G + c; if (L >= nwg) return false;
        int wgid = (int)L; { const int q = nwg / NXCD, r = nwg % NXCD, xcd = wgid % NXCD, off = wgid / NXCD; wgid = (xcd < r ? xcd * (q + 1) : r * (q + 1) + (xcd - r) * q) + off; }
        const int nig = WGM * nN, gid = wgid / nig, fm = gid * WGM, gsz = (nM - fm) < WGM ? (nM - fm) : WGM;
        u.pm = fm + ((wgid % nig) % gsz); u.pn = (wgid % nig) / gsz; u.e = 0; return true;
    }
};
struct MoeOrder {
    int nM, nN, nwg, G, c; const LAS int* blk_e; const LAS int* pads;
    __device__ void init(int nblk, int N, int G_, int c_, const LAS int* be, const LAS int* pd) { nM = nblk; nN = N / BM; nwg = nM * nN; G = G_; c = c_; blk_e = be; pads = pd; }
    __device__ bool next(int i, Unit& u) const {
        const long L = (long)i * G + c; if (L >= nwg) return false;
        int wgid = (int)L; { const int q = nwg / NXCD, r = nwg % NXCD, xcd = wgid % NXCD, off = wgid / NXCD; wgid = (xcd < r ? xcd * (q + 1) : r * (q + 1) + (xcd - r) * q) + off; }
        const int e = blk_e[wgid / nN], b0 = pads[e] >> 8, nb = (pads[e + 1] - pads[e]) >> 8, local = wgid - b0 * nN;
        u.pn = local / nb; u.pm = b0 + (local - u.pn * nb); u.e = e; return true;
    }
};

__device__ __forceinline__ unsigned cvt_pk_bf16(float lo, float hi) { unsigned r; asm volatile("v_cvt_pk_bf16_f32 %0, %1, %2" : "=v"(r) : "v"(lo), "v"(hi)); return r; }

struct EpiBf16 {
    static constexpr bool PERM = true;
    bf16* O; int ldc; const float* bias; int bias_stride; float scale;
    __device__ __forceinline__ void operator()(const f32x4 (&acc)[2][2][4][2], const Unit& u, int wr, int wc, int fr, int fq) const {
        const int row0 = u.pm * BM + wr * 64 + fr; const int col0 = u.pn * BM + wc * 32 + 8 * fq;
        const float* bp = bias ? bias + (size_t)u.e * bias_stride + col0 : nullptr;
        f32x4 bv[2][2];
#pragma unroll
        for (int bj = 0; bj < 2; ++bj)
#pragma unroll
            for (int n = 0; n < 2; ++n) bv[bj][n] = bias ? *(const f32x4*)(bp + bj * HALF + 4 * n) : (f32x4){0.f, 0.f, 0.f, 0.f};
#pragma unroll
        for (int ai = 0; ai < 2; ++ai)
#pragma unroll
            for (int m = 0; m < 4; ++m) { bf16* rowp = O + (size_t)(row0 + ai * HALF + m * 16) * ldc + col0;
#pragma unroll
                for (int bj = 0; bj < 2; ++bj) { f32x4 v0 = acc[ai][bj][m][0] * scale + bv[bj][0], v1 = acc[ai][bj][m][1] * scale + bv[bj][1];
                    v4u w; w.x = cvt_pk_bf16(v0[0], v0[1]); w.y = cvt_pk_bf16(v0[2], v0[3]); w.z = cvt_pk_bf16(v1[0], v1[1]); w.w = cvt_pk_bf16(v1[2], v1[3]);
                    st16_wt(rowp + bj * HALF, w); } }
    }
};
struct EpiKV {
    static constexpr bool PERM = true;
    bf16* KVF; bf16* KM; const float* gk; const float* krss; const bf16* PROJ; LAS float* part;
    __device__ __forceinline__ void operator()(const f32x4 (&acc)[2][2][4][2], const Unit& u, int wr, int wc, int fr, int fq) const {
        asm volatile("" : "+v"(fr), "+v"(fq));
        typedef unsigned bu4 __attribute__((ext_vector_type(4)));
        const __amdgpu_buffer_rsrc_t rsV = __builtin_amdgcn_make_buffer_rsrc((void*)KVF, (short)0, 0x7FFFFFFF, 0x00020000);
        const __amdgpu_buffer_rsrc_t rsK = __builtin_amdgcn_make_buffer_rsrc((void*)KM, (short)0, 0x7FFFFFFF, 0x00020000);
        const __amdgpu_buffer_rsrc_t rsP = __builtin_amdgcn_make_buffer_rsrc((void*)PROJ, (short)0, 0x7FFFFFFF, 0x00020000);
        const __amdgpu_buffer_rsrc_t rsS = __builtin_amdgcn_make_buffer_rsrc((void*)krss, (short)0, 0x7FFFFFFF, 0x00020000);
        const int h = __builtin_amdgcn_readfirstlane(u.pn), pm = __builtin_amdgcn_readfirstlane(u.pm), rloc0 = wr * 64 + fr;
        const int i0 = 8 * wc + 2 * fq;
        const int voV = (rloc0 * 2048 + HALF + wc * 32 + 8 * fq) * 2, voK = (rloc0 * 1536 + wc * 32 + 8 * fq) * 2, voR = (rloc0 * 1536 + 128 + i0) * 2, voP = (rloc0 * 3840 + 640 + i0) * 2, voS = rloc0 * 4;
        const int sV = (pm * BM * 2048 + h * 256) * 2, sK = (pm * BM * 1536 + h * 192) * 2, sP = pm * BM * 3840 * 2, sS = pm * BM * 4;
#pragma unroll
        for (int ai = 0; ai < 2; ++ai)
#pragma unroll
            for (int m = 0; m < 4; ++m) { const f32x4 v0 = acc[ai][1][m][0], v1 = acc[ai][1][m][1];
                bu4 w; w.x = cvt_pk_bf16(v0[0], v0[1]); w.y = cvt_pk_bf16(v0[2], v0[3]); w.z = cvt_pk_bf16(v1[0], v1[1]); w.w = cvt_pk_bf16(v1[2], v1[3]);
                __builtin_amdgcn_raw_buffer_store_b128(w, rsV, voV, sV + (ai * HALF + m * 16) * 2048 * 2, WT_STORES ? 17 : 0); }
#pragma unroll
        for (int ai = 0; ai < 2; ++ai)
#pragma unroll
            for (int m = 0; m < 4; ++m) { const f32x4 a = acc[ai][0][m][0], b = acc[ai][0][m][1];
                float q = (a[0] * a[0] + a[1] * a[1]) + (a[2] * a[2] + a[3] * a[3]) + (b[0] * b[0] + b[1] * b[1]) + (b[2] * b[2] + b[3] * b[3]);
                q += __shfl_xor(q, 16); q += __shfl_xor(q, 32);
                if (fq == 0) part[wc * 256 + ai * HALF + m * 16 + rloc0] = q; }
        asm volatile("s_waitcnt lgkmcnt(0)" ::: "memory"); __builtin_amdgcn_s_barrier(); asm volatile("" ::: "memory");
        float g8[8];
#pragma unroll
        for (int j = 0; j < 8; ++j) g8[j] = gk[wc * 32 + 8 * fq + j];
        const float invf0 = __builtin_amdgcn_exp2f(-(float)i0 * (13.287712379549449f / 32.0f)), invf1 = __builtin_amdgcn_exp2f(-(float)(i0 + 1) * (13.287712379549449f / 32.0f));
        const float gr0 = gk[128 + i0], gr1 = gk[129 + i0], gs0 = gk[160 + i0], gs1 = gk[161 + i0];
#pragma unroll
        for (int ai = 0; ai < 2; ++ai)
#pragma unroll
            for (int m = 0; m < 4; ++m) { const int dl = ai * HALF + m * 16, rl = dl + rloc0;
                const float ks = __builtin_bit_cast(float, __builtin_amdgcn_raw_buffer_load_b32(rsS, voS, sS + dl * 4, 0));
                const unsigned x1 = __builtin_amdgcn_raw_buffer_load_b32(rsP, voP, sP + dl * 3840 * 2, 0), x2 = __builtin_amdgcn_raw_buffer_load_b32(rsP, voP + 64, sP + dl * 3840 * 2, 0);
                const float tot = (part[rl] + part[256 + rl]) + (part[512 + rl] + part[768 + rl]) + ks;
                const float rstd = 1.0f / sqrtf(tot * (1.f / 192.f) + 1e-6f);
                const f32x4 a = acc[ai][0][m][0], b = acc[ai][0][m][1];
                bu4 w; w.x = cvt_pk_bf16(a[0] * rstd * g8[0], a[1] * rstd * g8[1]); w.y = cvt_pk_bf16(a[2] * rstd * g8[2], a[3] * rstd * g8[3]);
                w.z = cvt_pk_bf16(b[0] * rstd * g8[4], b[1] * rstd * g8[5]); w.w = cvt_pk_bf16(b[2] * rstd * g8[6], b[3] * rstd * g8[7]);
                __builtin_amdgcn_raw_buffer_store_b128(w, rsK, voK, sK + dl * 1536 * 2, WT_STORES ? 17 : 0);
                const float pos = (float)((pm * BM + rl) & 8191);
                float r0 = pos * invf0 * 0.15915494309189535f, r1 = pos * invf1 * 0.15915494309189535f; r0 -= rintf(r0); r1 -= rintf(r1);
                const float sn0 = __builtin_amdgcn_sinf(r0), cs0 = __builtin_amdgcn_cosf(r0), sn1 = __builtin_amdgcn_sinf(r1), cs1 = __builtin_amdgcn_cosf(r1);
                const float a0 = __builtin_bit_cast(float, x1 << 16) * rstd * gr0, a1 = __builtin_bit_cast(float, x1 & 0xffff0000u) * rstd * gr1;
                const float b0 = __builtin_bit_cast(float, x2 << 16) * rstd * gs0, b1 = __builtin_bit_cast(float, x2 & 0xffff0000u) * rstd * gs1;
                __builtin_amdgcn_raw_buffer_store_b32(cvt_pk_bf16(a0 * cs0 - b0 * sn0, a1 * cs1 - b1 * sn1), rsK, voR, sK + dl * 1536 * 2, 0);
                __builtin_amdgcn_raw_buffer_store_b32(cvt_pk_bf16(b0 * cs0 + a0 * sn0, b1 * cs1 + a1 * sn1), rsK, voR + 64, sK + dl * 1536 * 2, 0); }
    }
};
__device__ __forceinline__ float swiglu(float g, float u) {
    g = fminf(g, 7.0f); u = fminf(fmaxf(u, -7.0f), 7.0f);
    const float s = __builtin_amdgcn_rcpf(1.0f + __builtin_amdgcn_exp2f(g * (-1.702f * 1.4426950408889634f)));
    return g * s * (u + 1.0f);
}
__device__ __forceinline__ unsigned pk4_fp8(float a, float b, float c, float d) {
    a = __builtin_amdgcn_fmed3f(a, 448.0f, -448.0f); b = __builtin_amdgcn_fmed3f(b, 448.0f, -448.0f); c = __builtin_amdgcn_fmed3f(c, 448.0f, -448.0f); d = __builtin_amdgcn_fmed3f(d, 448.0f, -448.0f);
    int w = __builtin_amdgcn_cvt_pk_fp8_f32(a, b, 0, false); w = __builtin_amdgcn_cvt_pk_fp8_f32(c, d, w, true); return (unsigned)w;
}
struct EpiGU {
    static constexpr bool PERM = true;
    unsigned char* O; int ldc; const float* bias; int bias_stride; float scale;
    __device__ __forceinline__ void operator()(const f32x4 (&acc)[2][2][4][2], const Unit& u, int wr, int wc, int fr, int fq) const {
        const int row0 = u.pm * BM + wr * 64 + fr; const int col0 = u.pn * BM + wc * 32 + 8 * fq;
        const float* bp = bias + (size_t)u.e * bias_stride + col0;
        f32x4 bv[2][2];
#pragma unroll
        for (int bj = 0; bj < 2; ++bj)
#pragma unroll
            for (int n = 0; n < 2; ++n) bv[bj][n] = *(const f32x4*)(bp + bj * HALF + 4 * n);
#pragma unroll
        for (int ai = 0; ai < 2; ++ai)
#pragma unroll
            for (int m = 0; m < 4; ++m) { unsigned char* rowp = O + (size_t)(row0 + ai * HALF + m * 16) * ldc + (col0 >> 1);
#pragma unroll
                for (int bj = 0; bj < 2; ++bj) { const f32x4 v0 = acc[ai][bj][m][0] * scale + bv[bj][0], v1 = acc[ai][bj][m][1] * scale + bv[bj][1];
                    *(unsigned*)(rowp + bj * (HALF / 2)) = pk4_fp8(swiglu(v0[0], v0[1]), swiglu(v0[2], v0[3]), swiglu(v1[0], v1[1]), swiglu(v1[2], v1[3])); } }
    }
};
struct EpiFp8 {
    static constexpr bool PERM = true;
    unsigned char* O; int ldc; const float* bias; int bias_stride; float scale;
    __device__ __forceinline__ void operator()(const f32x4 (&acc)[2][2][4][2], const Unit& u, int wr, int wc, int fr, int fq) const {
        const int row0 = u.pm * BM + wr * 64 + fr; const int col0 = u.pn * BM + wc * 32 + 8 * fq;
        const float* bp = bias + (size_t)u.e * bias_stride + col0;
        f32x4 bv[2][2];
#pragma unroll
        for (int bj = 0; bj < 2; ++bj)
#pragma unroll
            for (int n = 0; n < 2; ++n) bv[bj][n] = *(const f32x4*)(bp + bj * HALF + 4 * n);
#pragma unroll
        for (int ai = 0; ai < 2; ++ai)
#pragma unroll
            for (int m = 0; m < 4; ++m) { unsigned char* rowp = O + (size_t)(row0 + ai * HALF + m * 16) * ldc + col0;
#pragma unroll
                for (int bj = 0; bj < 2; ++bj) { const f32x4 v0 = acc[ai][bj][m][0] * scale + bv[bj][0], v1 = acc[ai][bj][m][1] * scale + bv[bj][1];
                    v2u w; w.x = pk4_fp8(v0[0], v0[1], v0[2], v0[3]); w.y = pk4_fp8(v1[0], v1[1], v1[2], v1[3]);
                    *(v2u*)(rowp + bj * HALF) = w; } }
    }
};
struct EpiResF32 {
    static constexpr bool PERM = false;
    const float* base; float* out; int ldc; bf16* out16;
    __device__ __forceinline__ void operator()(const f32x4 (&acc)[2][2][4][2], const Unit& u, int wr, int wc, int fr, int fq) const {
        const int row0 = u.pm * BM + wr * 64 + fr; const int col0 = u.pn * BM + wc * 32 + 4 * fq;
#pragma unroll
        for (int ai = 0; ai < 2; ++ai)
#pragma unroll
            for (int m = 0; m < 4; ++m) { const size_t off = (size_t)(row0 + ai * HALF + m * 16) * ldc + col0;
#pragma unroll
                for (int bj = 0; bj < 2; ++bj)
#pragma unroll
                    for (int n = 0; n < 2; ++n) { const f32x4 b = *(const f32x4*)(base + off + bj * HALF + n * 16); const f32x4 r = b + acc[ai][bj][m][n];
                        *(f32x4*)(out + off + bj * HALF + n * 16) = r;
                        if (out16) { v2u w; w.x = cvt_pk_bf16(r[0], r[1]); w.y = cvt_pk_bf16(r[2], r[3]); *(v2u*)(out16 + off + bj * HALF + n * 16) = w; } } }
    }
};

struct EpiResBf16 {
    static constexpr bool PERM = true;
    const float* base; bf16* out16; int ldc;
    __device__ __forceinline__ void operator()(const f32x4 (&acc)[2][2][4][2], const Unit& u, int wr, int wc, int fr, int fq) const {
        const int row0 = u.pm * BM + wr * 64 + fr; const int col0 = u.pn * BM + wc * 32 + 8 * fq;
#pragma unroll
        for (int ai = 0; ai < 2; ++ai)
#pragma unroll
            for (int m = 0; m < 4; ++m) { const size_t off = (size_t)(row0 + ai * HALF + m * 16) * ldc + col0;
#pragma unroll
                for (int bj = 0; bj < 2; ++bj) { const f32x4 b0 = *(const f32x4*)(base + off + bj * HALF), b1 = *(const f32x4*)(base + off + bj * HALF + 4);
                    const f32x4 r0 = b0 + acc[ai][bj][m][0], r1 = b1 + acc[ai][bj][m][1];
                    v4u w; w.x = cvt_pk_bf16(r0[0], r0[1]); w.y = cvt_pk_bf16(r0[2], r0[3]); w.z = cvt_pk_bf16(r1[0], r1[1]); w.w = cvt_pk_bf16(r1[2], r1[3]);
                    st16_wt(out16 + off + bj * HALF, w); } }
    }
};

template <class Epi, class Sched, bool ALIGN_EPI = false, bool SP2 = false, bool FP8 = false, bool GATHER = false>
__device__ __forceinline__ void gemm_phase(LAS unsigned char* lds, const Gemm g, const Sched& S, const Epi& E) {
    const int tid = threadIdx.x, wid = __builtin_amdgcn_readfirstlane(tid >> 6), lane = tid & 63, wr = wid >> 2, wc = wid & 3, fr = lane & 15, fq = lane >> 4;
    const int RB = g.rowbytes, nt = RB / 128;
    unsigned voffA[2], voffB[2]; int rowA[2], colA[2];
#pragma unroll
    for (int i = 0; i < 2; ++i) { int R, C; stage_rc(tid * 16 + i * 8192, R, C); const int Rb = Epi::PERM ? ((R & ~31) + perm32(R & 31)) : R;
        voffA[i] = (unsigned)(R * RB + C * 2); voffB[i] = (unsigned)(Rb * RB + C * 2); rowA[i] = R; colA[i] = C * 2; }
    unsigned cvA[2][2], nvA[2][2];
    const unsigned kstep = 128u;
    const unsigned hstep = (unsigned)HALF * (unsigned)RB;
    const unsigned tstep = 2u * hstep;
    const __amdgpu_buffer_rsrc_t rsA = __builtin_amdgcn_make_buffer_rsrc((void*)g.A, (short)0, 0x7FFFFFFF, 0x00020000);
    const __amdgpu_buffer_rsrc_t rsB = __builtin_amdgcn_make_buffer_rsrc((void*)g.Bt, (short)0, 0x7FFFFFFF, 0x00020000);
    const unsigned ldsw = (unsigned)wid * 1024u;
    const int aoff = lds_byte(wr * 64 + fr, fq * 8), boff = lds_byte(wc * 32 + fr, fq * 8);
#define PG8_SA(b, h) (((b) * 2 + (h)) * HTB)
#define PG8_SB(b, h) ((4 + (b) * 2 + (h)) * HTB)
#define PG8_STAGE(bufoff, soff, voff) do { _Pragma("unroll") for (int _i = 0; _i < 2; ++_i) \
        __builtin_amdgcn_raw_ptr_buffer_load_lds(rs_##voff, (LAS void*)(lds + (bufoff) + ldsw + _i * 8192), 16, (int)(voff)[_i], (int)(soff), 0, 0); } while (0)
#define rs_voffA rsA
#define rs_voffB rsB
#define PG8_STAGE_A(bufoff, soff, h, NXT) do { _Pragma("unroll") for (int _i = 0; _i < 2; ++_i) { unsigned vo_, so_; \
        if constexpr (GATHER) { vo_ = (NXT) ? nvA[h][_i] : cvA[h][_i]; so_ = (soff); } else { vo_ = voffA[_i]; so_ = (soff) + (h) * hstep; } \
        __builtin_amdgcn_raw_ptr_buffer_load_lds(rsA, (LAS void*)(lds + (bufoff) + ldsw + _i * 8192), 16, (int)vo_, (int)so_, 0, 0); } } while (0)
#define PG8_LD16(off) (*(const LAS v4i*)(lds + (off)))
#define PG8_LDA(dst, b, h) do { _Pragma("unroll") for (int m = 0; m < 4; ++m) { if constexpr (FP8) { const v4i lo_ = PG8_LD16(PG8_SA(b, h) + aoff + m * 2048), hi_ = PG8_LD16(PG8_SA(b, h) + aoff + m * 2048 + 1024); dst##8[m] = __builtin_shufflevector(lo_, hi_, 0, 1, 2, 3, 4, 5, 6, 7); } \
        else { _Pragma("unroll") for (int k = 0; k < 2; ++k) dst[m][k] = *(const LAS bf16x8*)(lds + PG8_SA(b, h) + aoff + m * 2048 + k * 1024); } } } while (0)
#define PG8_LDB(dst, b, h) do { _Pragma("unroll") for (int n = 0; n < 2; ++n) { if constexpr (FP8) { const v4i lo_ = PG8_LD16(PG8_SB(b, h) + boff + n * 2048), hi_ = PG8_LD16(PG8_SB(b, h) + boff + n * 2048 + 1024); dst##8[n] = __builtin_shufflevector(lo_, hi_, 0, 1, 2, 3, 4, 5, 6, 7); } \
        else { _Pragma("unroll") for (int k = 0; k < 2; ++k) dst[n][k] = *(const LAS bf16x8*)(lds + PG8_SB(b, h) + boff + n * 2048 + k * 1024); } } } while (0)
#define PG8_MMA(ai, bj, At, Bt) do { __builtin_amdgcn_s_setprio(1); _Pragma("unroll") for (int m = 0; m < 4; ++m) _Pragma("unroll") for (int n = 0; n < 2; ++n) { \
        if constexpr (FP8) { asm volatile("v_mfma_scale_f32_16x16x128_f8f6f4 %0, %1, %2, %0, %3, %3 op_sel_hi:[0,0,0]" : "+v"(acc[ai][bj][m][n]) : "v"(Bt##8[n]), "v"(At##8[m]), "v"(sc1)); } \
        else { _Pragma("unroll") for (int k = 0; k < 2; ++k) acc[ai][bj][m][n] = __builtin_amdgcn_mfma_f32_16x16x32_bf16(Bt[n][k], At[m][k], acc[ai][bj][m][n], 0, 0, 0); } } \
        __builtin_amdgcn_s_setprio(0); } while (0)
#define PG8_WAIT_V(n) asm volatile("s_waitcnt vmcnt(" #n ")" ::: "memory")
#define PG8_WAIT_L(n) asm volatile("s_waitcnt lgkmcnt(" #n ")" ::: "memory")
#define PG8_BAR __builtin_amdgcn_s_barrier()
#define PG8_SCHED __builtin_amdgcn_sched_barrier(0)
    Unit cur, nxt; int ui = 0;
    if (!S.next(0, cur)) return;
    f32x4 acc[2][2][4][2];
#pragma unroll
    for (int a = 0; a < 2; ++a)
#pragma unroll
        for (int b = 0; b < 2; ++b)
#pragma unroll
            for (int m = 0; m < 4; ++m)
#pragma unroll
                for (int n = 0; n < 2; ++n) acc[a][b][m][n] = (f32x4){0.f, 0.f, 0.f, 0.f};
    int sc1 = 0x7F7F7F7F; asm volatile("" : "+v"(sc1));
    bf16x8 At[4][2], B0[2][2], B1[2][2]; v8i At8[4], B08[2], B18[2];
    unsigned cA = GATHER ? 0u : (unsigned)__builtin_amdgcn_readfirstlane(cur.pm) * tstep, cB = (unsigned)__builtin_amdgcn_readfirstlane(cur.e) * (unsigned)g.bstride_e + (unsigned)__builtin_amdgcn_readfirstlane(cur.pn) * tstep;
    const __amdgpu_buffer_rsrc_t rsI = __builtin_amdgcn_make_buffer_rsrc((void*)g.rowidx, (short)0, 0x7FFFFFFF, 0x00020000);
    if constexpr (GATHER) {
#pragma unroll
        for (int h = 0; h < 2; ++h)
#pragma unroll
            for (int i = 0; i < 2; ++i) cvA[h][i] = (unsigned)g.rowidx[cur.pm * BM + h * HALF + rowA[i]] * (unsigned)RB + (unsigned)colA[i];
    }
    if constexpr (SP2) {
        PG8_STAGE(PG8_SB(0, 0), cB, voffB); PG8_STAGE(PG8_SB(0, 1), cB + hstep, voffB); PG8_STAGE_A(PG8_SA(0, 0), cA, 0, false); PG8_STAGE_A(PG8_SA(0, 1), cA, 1, false);
        if (wr == 1) PG8_BAR;
        PG8_WAIT_V(2); PG8_BAR;
        PG8_STAGE(PG8_SB(1, 0), cB + kstep, voffB); PG8_STAGE_A(PG8_SA(1, 0), cA + kstep, 0, false); PG8_STAGE(PG8_SB(1, 1), cB + hstep + kstep, voffB);
        PG8_WAIT_V(6); PG8_BAR;
    } else {
        PG8_STAGE(PG8_SB(0, 0), cB, voffB); PG8_STAGE_A(PG8_SA(0, 0), cA, 0, false); PG8_STAGE(PG8_SB(0, 1), cB + hstep, voffB); PG8_STAGE_A(PG8_SA(0, 1), cA, 1, false);
        if (wr == 1) PG8_BAR;
        PG8_WAIT_V(4); PG8_BAR;
        PG8_STAGE(PG8_SB(1, 0), cB + kstep, voffB); PG8_STAGE_A(PG8_SA(1, 0), cA + kstep, 0, false); PG8_STAGE(PG8_SB(1, 1), cB + hstep + kstep, voffB);
        PG8_WAIT_V(6); PG8_BAR;
    }
    for (;;) {
        const bool has_next = S.next(ui + 1, nxt);
        const unsigned nA = (has_next && !GATHER) ? (unsigned)__builtin_amdgcn_readfirstlane(nxt.pm) * tstep : cA;
        LAS int* itab = g.idxtab + (ui & 1) * BM;
        if constexpr (GATHER) { if (has_next && wid < 4) __builtin_amdgcn_raw_ptr_buffer_load_lds(rsI, (LAS void*)(itab + wid * 64), 4, (int)(lane * 4), (int)(((unsigned)__builtin_amdgcn_readfirstlane(nxt.pm) * BM + wid * 64) * 4u), 0, 0); }
        const unsigned nB = has_next ? (unsigned)__builtin_amdgcn_readfirstlane(nxt.e) * (unsigned)g.bstride_e + (unsigned)__builtin_amdgcn_readfirstlane(nxt.pn) * tstep : cB;
        for (int t = 0; t < nt; t += 2) {
            const bool last = (t == nt - 2);
            const unsigned a1 = cA + (unsigned)(t + 1) * kstep;
            const unsigned a2 = last ? nA : cA + (unsigned)(t + 2) * kstep, b2 = last ? nB : cB + (unsigned)(t + 2) * kstep;
            const unsigned a3 = a2 + kstep, b3 = b2 + kstep;
            if constexpr (GATHER) { if (last && has_next) {
                _Pragma("unroll") for (int h = 0; h < 2; ++h) _Pragma("unroll") for (int i = 0; i < 2; ++i) nvA[h][i] = (unsigned)itab[h * HALF + rowA[i]] * (unsigned)RB + (unsigned)colA[i]; }
              else if (last) { _Pragma("unroll") for (int h = 0; h < 2; ++h) _Pragma("unroll") for (int i = 0; i < 2; ++i) nvA[h][i] = cvA[h][i]; } }
            if constexpr (SP2) {
#if PG8_LATE_ISSUE == 2
            PG8_LDB(B0, 0, 0); PG8_LDB(B1, 0, 1); PG8_SCHED; PG8_LDA(At, 0, 0); PG8_STAGE_A(PG8_SA(1, 1), a1, 1, false);
            PG8_WAIT_V(8); PG8_WAIT_L(0); PG8_BAR; PG8_MMA(0, 0, At, B0); PG8_MMA(0, 1, At, B1); PG8_BAR; PG8_SCHED;
            PG8_LDA(At, 0, 1); PG8_STAGE(PG8_SB(0, 0), b2, voffB); PG8_STAGE(PG8_SB(0, 1), b2 + hstep, voffB);
            PG8_WAIT_V(6); PG8_WAIT_L(0); PG8_BAR; PG8_MMA(1, 0, At, B0); PG8_STAGE_A(PG8_SA(0, 0), a2, 0, last); PG8_MMA(1, 1, At, B1); PG8_BAR; PG8_SCHED;
            PG8_LDB(B0, 1, 0); PG8_LDB(B1, 1, 1); PG8_SCHED; PG8_LDA(At, 1, 0); PG8_STAGE_A(PG8_SA(0, 1), a2, 1, last);
            PG8_WAIT_V(8); PG8_WAIT_L(0); PG8_BAR; PG8_MMA(0, 0, At, B0); PG8_MMA(0, 1, At, B1); PG8_BAR; PG8_SCHED;
            PG8_LDA(At, 1, 1); PG8_STAGE(PG8_SB(1, 0), b3, voffB); PG8_STAGE(PG8_SB(1, 1), b3 + hstep, voffB);
            PG8_WAIT_V(6); PG8_WAIT_L(0); PG8_BAR; PG8_MMA(1, 0, At, B0); PG8_STAGE_A(PG8_SA(1, 0), a3, 0, last); PG8_MMA(1, 1, At, B1); PG8_BAR; PG8_SCHED;
#else
            PG8_LDB(B0, 0, 0); PG8_LDB(B1, 0, 1); PG8_SCHED; PG8_LDA(At, 0, 0); PG8_STAGE_A(PG8_SA(1, 1), a1, 1, false);
            PG8_WAIT_V(8); PG8_WAIT_L(0); PG8_BAR; PG8_MMA(0, 0, At, B0); PG8_MMA(0, 1, At, B1); PG8_BAR; PG8_SCHED;
            PG8_LDA(At, 0, 1); PG8_STAGE(PG8_SB(0, 0), b2, voffB); PG8_STAGE(PG8_SB(0, 1), b2 + hstep, voffB); PG8_STAGE_A(PG8_SA(0, 0), a2, 0, last);
            PG8_WAIT_V(8); PG8_WAIT_L(0); PG8_BAR; PG8_MMA(1, 0, At, B0); PG8_MMA(1, 1, At, B1); PG8_BAR; PG8_SCHED;
            PG8_LDB(B0, 1, 0); PG8_LDB(B1, 1, 1); PG8_SCHED; PG8_LDA(At, 1, 0); PG8_STAGE_A(PG8_SA(0, 1), a2, 1, last);
            PG8_WAIT_V(8); PG8_WAIT_L(0); PG8_BAR; PG8_MMA(0, 0, At, B0); PG8_MMA(0, 1, At, B1); PG8_BAR; PG8_SCHED;
            PG8_LDA(At, 1, 1); PG8_STAGE(PG8_SB(1, 0), b3, voffB); PG8_STAGE(PG8_SB(1, 1), b3 + hstep, voffB); PG8_STAGE_A(PG8_SA(1, 0), a3, 0, last);
            PG8_WAIT_V(8); PG8_WAIT_L(0); PG8_BAR; PG8_MMA(1, 0, At, B0); PG8_MMA(1, 1, At, B1); PG8_BAR; PG8_SCHED;
#endif
            } else {
            PG8_LDB(B0, 0, 0); PG8_SCHED; PG8_LDA(At, 0, 0); PG8_STAGE_A(PG8_SA(1, 1), a1, 1, false);
            PG8_WAIT_L(8); PG8_BAR; PG8_WAIT_L(0); PG8_MMA(0, 0, At, B0); PG8_BAR; PG8_SCHED;
            PG8_LDB(B1, 0, 1); PG8_STAGE(PG8_SB(0, 0), b2, voffB);
            PG8_BAR; PG8_WAIT_L(0); PG8_MMA(0, 1, At, B1); PG8_BAR;
            PG8_LDA(At, 0, 1); PG8_STAGE_A(PG8_SA(0, 0), a2, 0, last);
            PG8_BAR; PG8_WAIT_L(0); PG8_MMA(1, 0, At, B0); PG8_BAR; PG8_SCHED;
            PG8_STAGE(PG8_SB(0, 1), b2 + hstep, voffB);
            PG8_WAIT_V(6); PG8_BAR; PG8_MMA(1, 1, At, B1); PG8_BAR;
            PG8_LDB(B0, 1, 0); PG8_SCHED; PG8_LDA(At, 1, 0); PG8_STAGE_A(PG8_SA(0, 1), a2, 1, last);
            PG8_WAIT_L(8); PG8_BAR; PG8_WAIT_L(0); PG8_MMA(0, 0, At, B0); PG8_BAR; PG8_SCHED;
            PG8_LDB(B1, 1, 1); PG8_STAGE(PG8_SB(1, 0), b3, voffB);
            PG8_BAR; PG8_WAIT_L(0); PG8_MMA(0, 1, At, B1); PG8_BAR;
            PG8_LDA(At, 1, 1); PG8_STAGE_A(PG8_SA(1, 0), a3, 0, last);
            PG8_BAR; PG8_WAIT_L(0); PG8_MMA(1, 0, At, B0); PG8_BAR; PG8_SCHED;
            PG8_STAGE(PG8_SB(1, 1), b3 + hstep, voffB);
            PG8_WAIT_V(6); PG8_BAR; PG8_MMA(1, 1, At, B1); PG8_BAR;
            }
        }
        if constexpr (ALIGN_EPI) { if (wr == 0) PG8_BAR; }
        if constexpr (FP8) asm volatile("s_nop 15\n\ts_nop 15" ::: "memory");
        E(acc, cur, wr, wc, fr, fq);
        if (!has_next) break;
#pragma unroll
        for (int a = 0; a < 2; ++a)
#pragma unroll
            for (int b = 0; b < 2; ++b)
#pragma unroll
                for (int m = 0; m < 4; ++m)
#pragma unroll
                    for (int n = 0; n < 2; ++n) acc[a][b][m][n] = (f32x4){0.f, 0.f, 0.f, 0.f};
        cur = nxt; cA = nA; cB = nB; ++ui;
        if constexpr (GATHER) { _Pragma("unroll") for (int h = 0; h < 2; ++h) _Pragma("unroll") for (int i = 0; i < 2; ++i) cvA[h][i] = nvA[h][i]; }
        if constexpr (ALIGN_EPI) { if (wr == 1) PG8_BAR; }
    }
    PG8_WAIT_V(0);
    if constexpr (!ALIGN_EPI) { if (wr == 0) PG8_BAR; }
    PG8_BAR;
#undef PG8_SA
#undef PG8_SB
#undef PG8_STAGE
#undef PG8_STAGE_A
#undef rs_voffA
#undef rs_voffB
#undef PG8_LD16
#undef PG8_LDA
#undef PG8_LDB
#undef PG8_MMA
#undef PG8_WAIT_V
#undef PG8_WAIT_L
#undef PG8_BAR
#undef PG8_SCHED
}
}

namespace att {
constexpr int KVBLK = 64;
constexpr int SHM_V = KVBLK * 128 * 2;
constexpr int OFF_V = 0, OFF_K = 3 * SHM_V;
constexpr int OFF_WS = OFF_K + 3 * 24576;
constexpr int OFF_TAB = OFF_WS + 8 * 256;
constexpr int OFF_GQ = OFF_TAB + 1024;
constexpr int ATT_LDS_END = OFF_GQ + 1024;
static_assert(ATT_LDS_END <= RING_BYTES, "attention LDS");
constexpr float THR2 = 8.0f * 1.4426950408889634f;

__device__ __forceinline__ int crow(int r, int hi) { return (r & 3) + 8 * (r >> 2) + 4 * hi; }
__device__ __forceinline__ unsigned cvtpk(float lo, float hi) { unsigned r; asm volatile("v_cvt_pk_bf16_f32 %0, %1, %2" : "=v"(r) : "v"(lo), "v"(hi)); return r; }
__device__ __forceinline__ int v_rd_base(int lane) { return ((lane & 3) << 3) | (((lane >> 2) & 3) << 6) | (((lane >> 4) & 1) << 5) | (((lane >> 5) & 1) << 8); }
constexpr int v_rd_off(int d0, int ks, int half) { return d0 * 512 + ks * 4096 + half * 2048; }
template <int OFF> __device__ __forceinline__ s16x4 tr_read(int vb) {
    s16x4 r; asm volatile("ds_read_b64_tr_b16 %0, %1 offset:%2" : "=&v"(r) : "v"(vb), "i"(OFF) : "memory"); return r;
}
template <int D0> __device__ __forceinline__ void pv_one(f32x16& od, int vb, bf16x8 pa0, bf16x8 pa1, bf16x8 pa2, bf16x8 pa3) {
    const s16x4 l0 = tr_read<v_rd_off(D0, 0, 0)>(vb), h0 = tr_read<v_rd_off(D0, 0, 1)>(vb), l1 = tr_read<v_rd_off(D0, 1, 0)>(vb), h1 = tr_read<v_rd_off(D0, 1, 1)>(vb);
    const s16x4 l2 = tr_read<v_rd_off(D0, 2, 0)>(vb), h2 = tr_read<v_rd_off(D0, 2, 1)>(vb), l3 = tr_read<v_rd_off(D0, 3, 0)>(vb), h3 = tr_read<v_rd_off(D0, 3, 1)>(vb);
    asm volatile("s_waitcnt lgkmcnt(0)" ::: "memory"); __builtin_amdgcn_sched_barrier(0);
#define PK(L, H) (bf16x8){L[0], L[1], L[2], L[3], H[0], H[1], H[2], H[3]}
    od = __builtin_amdgcn_mfma_f32_32x32x16_bf16(pa0, PK(l0, h0), od, 0, 0, 0);
    od = __builtin_amdgcn_mfma_f32_32x32x16_bf16(pa1, PK(l1, h1), od, 0, 0, 0);
    od = __builtin_amdgcn_mfma_f32_32x32x16_bf16(pa2, PK(l2, h2), od, 0, 0, 0);
    od = __builtin_amdgcn_mfma_f32_32x32x16_bf16(pa3, PK(l3, h3), od, 0, 0, 0);
#undef PK
}
__device__ __forceinline__ void pv_pre(s16x4 (&vf)[8], int vb) {
    vf[0] = tr_read<v_rd_off(0, 0, 0)>(vb); vf[1] = tr_read<v_rd_off(0, 0, 1)>(vb); vf[2] = tr_read<v_rd_off(0, 1, 0)>(vb); vf[3] = tr_read<v_rd_off(0, 1, 1)>(vb);
    vf[4] = tr_read<v_rd_off(0, 2, 0)>(vb); vf[5] = tr_read<v_rd_off(0, 2, 1)>(vb); vf[6] = tr_read<v_rd_off(0, 3, 0)>(vb); vf[7] = tr_read<v_rd_off(0, 3, 1)>(vb);
}
__device__ __forceinline__ void pv_all_pre(f32x16 (&o)[4], int vb, bf16x8 pa0, bf16x8 pa1, bf16x8 pa2, bf16x8 pa3, const s16x4 (&vf)[8]) {
    asm volatile("s_waitcnt lgkmcnt(0)" ::: "memory"); __builtin_amdgcn_sched_barrier(0);
#define PK(L, H) (bf16x8){L[0], L[1], L[2], L[3], H[0], H[1], H[2], H[3]}
    o[0] = __builtin_amdgcn_mfma_f32_32x32x16_bf16(pa0, PK(vf[0], vf[1]), o[0], 0, 0, 0);
    o[0] = __builtin_amdgcn_mfma_f32_32x32x16_bf16(pa1, PK(vf[2], vf[3]), o[0], 0, 0, 0);
    o[0] = __builtin_amdgcn_mfma_f32_32x32x16_bf16(pa2, PK(vf[4], vf[5]), o[0], 0, 0, 0);
    o[0] = __builtin_amdgcn_mfma_f32_32x32x16_bf16(pa3, PK(vf[6], vf[7]), o[0], 0, 0, 0);
#undef PK
    pv_one<1>(o[1], vb, pa0, pa1, pa2, pa3); pv_one<2>(o[2], vb, pa0, pa1, pa2, pa3); pv_one<3>(o[3], vb, pa0, pa1, pa2, pa3);
}
__device__ __forceinline__ void pv_all(f32x16 (&o)[4], int vb, bf16x8 pa0, bf16x8 pa1, bf16x8 pa2, bf16x8 pa3) {
    pv_one<0>(o[0], vb, pa0, pa1, pa2, pa3); pv_one<1>(o[1], vb, pa0, pa1, pa2, pa3); pv_one<2>(o[2], vb, pa0, pa1, pa2, pa3); pv_one<3>(o[3], vb, pa0, pa1, pa2, pa3);
}
#ifndef QK_AHEAD64
#define QK_AHEAD64 1
#endif
#ifndef QK_AHEAD
#define QK_AHEAD 4
#endif
template <int DQK, bool BIAS, bool VPRE = false> __device__ __forceinline__ void qkt(f32x16& p0, f32x16& p1, const LAS unsigned char* Ks, const bf16x8 (&qr)[DQK / 16], int r32, int hi, int vb = 0, s16x4 (*vf)[8] = nullptr) {
    constexpr int KROW = DQK * 2, N = DQK / 16;
#pragma unroll
    for (int r = 0; r < 16; ++r) { p0[r] = 0.f; p1[r] = 0.f; }
#define QK_LO(d0) ((((((d0) & 3) * 32 + hi * 16) ^ (((r32 >> 1) & 7) << 4)) + r32 * KROW) + ((d0) >> 2) * 128)
    if constexpr (DQK == 192 && QK_AHEAD > 0) {
        bf16x8 f0[N], f1[N];
#pragma unroll
        for (int d0 = 0; d0 < QK_AHEAD; ++d0) { f0[d0] = *(const LAS bf16x8*)(Ks + QK_LO(d0)); f1[d0] = *(const LAS bf16x8*)(Ks + QK_LO(d0) + 32 * KROW); }
#pragma unroll
        for (int d0 = 0; d0 < N; ++d0) {
            if (d0 + QK_AHEAD < N) { f0[d0 + QK_AHEAD] = *(const LAS bf16x8*)(Ks + QK_LO(d0 + QK_AHEAD)); f1[d0 + QK_AHEAD] = *(const LAS bf16x8*)(Ks + QK_LO(d0 + QK_AHEAD) + 32 * KROW); }
            if constexpr (VPRE) { if (d0 == N - 3) pv_pre(*vf, vb); }
            __builtin_amdgcn_sched_barrier(0);
            p0 = __builtin_amdgcn_mfma_f32_32x32x16_bf16(f0[d0], qr[d0], p0, 0, 0, 0);
            p1 = __builtin_amdgcn_mfma_f32_32x32x16_bf16(f1[d0], qr[d0], p1, 0, 0, 0);
            __builtin_amdgcn_sched_barrier(0);
        }
    } else if constexpr (DQK == 64 && QK_AHEAD64) {
        bf16x8 f0[N], f1[N];
#pragma unroll
        for (int d0 = 0; d0 < N; ++d0) { f0[d0] = *(const LAS bf16x8*)(Ks + QK_LO(d0)); f1[d0] = *(const LAS bf16x8*)(Ks + QK_LO(d0) + 32 * KROW); }
        __builtin_amdgcn_sched_barrier(0);
#pragma unroll
        for (int d0 = 0; d0 < N; ++d0) {
            p0 = __builtin_amdgcn_mfma_f32_32x32x16_bf16(f0[d0], qr[d0], p0, 0, 0, 0);
            p1 = __builtin_amdgcn_mfma_f32_32x32x16_bf16(f1[d0], qr[d0], p1, 0, 0, 0); }
    } else {
#pragma unroll
        for (int d0 = 0; d0 < N; ++d0) {
            const bf16x8 b0 = *(const LAS bf16x8*)(Ks + QK_LO(d0));
            const bf16x8 b1 = *(const LAS bf16x8*)(Ks + QK_LO(d0) + 32 * KROW);
            p0 = __builtin_amdgcn_mfma_f32_32x32x16_bf16(b0, qr[d0], p0, 0, 0, 0);
            p1 = __builtin_amdgcn_mfma_f32_32x32x16_bf16(b1, qr[d0], p1, 0, 0, 0); }
    }
#undef QK_LO
}
#ifndef FIXMAX
#define FIXMAX 1
#endif
#if FIXMAX
template <bool BIAS, bool NOEXP = false> __device__ __forceinline__ void partialSM(f32x16& p0, f32x16& p1, const LAS float* tb  , bool nearT) {
    if (BIAS && nearT) {
#pragma unroll
        for (int r = 0; r < 16; ++r) { const int ko = (r & 3) + 8 * (r >> 2); p0[r] += tb[ko]; p1[r] += tb[ko + 32]; }
    }
#pragma unroll
    for (int r = 0; r < 16; ++r) p0[r] = NOEXP ? p0[r] * 0.001f : __builtin_amdgcn_exp2f(p0[r]);
}
template <bool NOEXP = false> __device__ __forceinline__ void finishSM(f32x16& p0, f32x16& p1, float& l_reg, bf16x8& pa0, bf16x8& pa1, bf16x8& pa2, bf16x8& pa3) {
#pragma unroll
    for (int r = 0; r < 16; ++r) p1[r] = NOEXP ? p1[r] * 0.001f : __builtin_amdgcn_exp2f(p1[r]);
    float ps = 0.f;
#pragma unroll
    for (int r = 0; r < 16; ++r) ps += p0[r];
#pragma unroll
    for (int r = 0; r < 16; ++r) ps += p1[r];
    l_reg += ps;
#define PK4(P, BASE, OUT) do { unsigned a0 = cvtpk(P[BASE + 0], P[BASE + 1]), a1 = cvtpk(P[BASE + 2], P[BASE + 3]);   \
    unsigned b0_ = cvtpk(P[BASE + 4], P[BASE + 5]), b1_ = cvtpk(P[BASE + 6], P[BASE + 7]);                              \
    auto r0 = __builtin_amdgcn_permlane32_swap(a0, b0_, false, false); auto r1 = __builtin_amdgcn_permlane32_swap(a1, b1_, false, false); \
    v4u w = {r0[0], r1[0], r0[1], r1[1]}; OUT = *reinterpret_cast<bf16x8*>(&w); } while (0)
    PK4(p0, 0, pa0); PK4(p0, 8, pa1); PK4(p1, 0, pa2); PK4(p1, 8, pa3);
#undef PK4
}
#else
template <bool BIAS, bool NOEXP = false> __device__ __forceinline__ void partialSM(f32x16& p0, f32x16& p1, float& m_reg, float& alpha, float C, const LAS float* tabL, int relb  , bool nearT) {
    const bool perElem = BIAS && nearT;
    float bf = 0.f;
    if (perElem) { const LAS float* tb = tabL + relb;
#pragma unroll
        for (int r = 0; r < 16; ++r) { const int ko = (r & 3) + 8 * (r >> 2); p0[r] = fmaf(p0[r], C, tb[ko]); p1[r] = fmaf(p1[r], C, tb[ko + 32]); }
    } else if (BIAS) bf = tabL[0];
    float pmax = p0[0];
#pragma unroll
    for (int r = 1; r < 16; ++r) pmax = fmaxf(pmax, p0[r]);
#pragma unroll
    for (int r = 0; r < 16; ++r) pmax = fmaxf(pmax, p1[r]);
    { auto rr = __builtin_amdgcn_permlane32_swap(__float_as_uint(pmax), __float_as_uint(pmax), false, false);
      pmax = fmaxf(__uint_as_float(rr[0]), __uint_as_float(rr[1])); }
    if (!perElem) pmax = fmaf(pmax, C, bf);
    if (__builtin_expect(__all(pmax - m_reg <= THR2), 1)) { alpha = 1.f; }
    else { const float mn = fmaxf(m_reg, pmax); alpha = __builtin_amdgcn_exp2f(m_reg - mn); m_reg = mn; }
    if (perElem) {
#pragma unroll
        for (int r = 0; r < 16; ++r) { p0[r] -= m_reg; p1[r] -= m_reg; }
    } else { const float sh = bf - m_reg;
#pragma unroll
        for (int r = 0; r < 16; ++r) { p0[r] = fmaf(p0[r], C, sh); p1[r] = fmaf(p1[r], C, sh); }
    }
#pragma unroll
    for (int r = 0; r < 16; ++r) p0[r] = NOEXP ? p0[r] * 0.001f : __builtin_amdgcn_exp2f(p0[r]);
}
template <bool NOEXP = false> __device__ __forceinline__ void finishSM(f32x16& p0, f32x16& p1, float alpha, float& l_reg, bf16x8& pa0, bf16x8& pa1, bf16x8& pa2, bf16x8& pa3) {
#pragma unroll
    for (int r = 0; r < 16; ++r) p1[r] = NOEXP ? p1[r] * 0.001f : __builtin_amdgcn_exp2f(p1[r]);
    float ps = 0.f;
#pragma unroll
    for (int r = 0; r < 16; ++r) ps += p0[r];
#pragma unroll
    for (int r = 0; r < 16; ++r) ps += p1[r];
    { auto rr = __builtin_amdgcn_permlane32_swap(__float_as_uint(ps), __float_as_uint(ps), false, false);
      ps = __uint_as_float(rr[0]) + __uint_as_float(rr[1]); }
    l_reg = l_reg * alpha + ps;
#define PK4(P, BASE, OUT) do { unsigned a0 = cvtpk(P[BASE + 0], P[BASE + 1]), a1 = cvtpk(P[BASE + 2], P[BASE + 3]);   \
    unsigned b0_ = cvtpk(P[BASE + 4], P[BASE + 5]), b1_ = cvtpk(P[BASE + 6], P[BASE + 7]);                              \
    auto r0 = __builtin_amdgcn_permlane32_swap(a0, b0_, false, false); auto r1 = __builtin_amdgcn_permlane32_swap(a1, b1_, false, false); \
    v4u w = {r0[0], r1[0], r0[1], r1[1]}; OUT = *reinterpret_cast<bf16x8*>(&w); } while (0)
    PK4(p0, 0, pa0); PK4(p0, 8, pa1); PK4(p1, 0, pa2); PK4(p1, 8, pa3);
#undef PK4
}

#endif

template <int DQK, bool BIAS, int EPI  , int PIPE  , int ABL = 0, int QPREP = 0  >
__device__ __forceinline__ void attn_unit(const bf16* __restrict__ Qb, int LDQ, const bf16* Kh, int LDK, const bf16* Vh, int LDV,
                                          int q0, float C, float nM2  , float* Of, bf16* __restrict__ Ob, int LDO, LAS unsigned char* lds, float lam = 0.f, const float* subg = nullptr, float post = 1.f, int LDOF = 0) {
    constexpr int KROW = DQK * 2;
    constexpr int SHM_K = KVBLK * KROW;
    constexpr int NKI = SHM_K / 8192;
    constexpr int NVI = SHM_V / 8192;
    static_assert(NVI == 2 && (NKI == 1 || NKI == 3), "vmcnt literals below");
    int tid_ = threadIdx.x; asm volatile("" : "+v"(tid_));
    const int tid = tid_, wid = __builtin_amdgcn_readfirstlane(tid >> 6), lane = tid & 63, r32 = lane & 31, hi = lane >> 5;
    LAS unsigned char* V_lds = lds + OFF_V; LAS unsigned char* K_lds = lds + OFF_K;
    LAS float* ws = (LAS float*)(lds + OFF_WS) + wid * 64; LAS float* li_l = ws; LAS float* al_l = ws + 32;
    const LAS float* tabL = (const LAS float*)(lds + OFF_TAB);
    const int NT = q0 / KVBLK + 4;
    const int my_last = (q0 + wid * 32) / KVBLK;
    const int qw0 = q0 + wid * 32, qpos = qw0 + r32;
    bf16x8 qr[DQK / 16];
#define Q_LOAD_PREP() do { \
    { const bf16* Qw = Qb + (size_t)(wid * 32 + r32) * LDQ + hi * 8; \
_Pragma("unroll") \
      for (int d0 = 0; d0 < DQK / 16; ++d0) qr[d0] = *(const bf16x8*)(Qw + d0 * 16); } \
    if constexpr (QPREP != 0) { \
        const LAS float* gq = (const LAS float*)(lds + OFF_GQ) + (QPREP == 1 ? 0 : 192) + hi * 8; \
        float ss = 0.f; \
_Pragma("unroll") \
        for (int d0 = 0; d0 < DQK / 16; ++d0) { const v4u w = __builtin_bit_cast(v4u, qr[d0]); \
            ss += bflo(w.x) * bflo(w.x) + bfhi(w.x) * bfhi(w.x) + bflo(w.y) * bflo(w.y) + bfhi(w.y) * bfhi(w.y) + bflo(w.z) * bflo(w.z) + bfhi(w.z) * bfhi(w.z) + bflo(w.w) * bflo(w.w) + bfhi(w.w) * bfhi(w.w); } \
        { auto rr = __builtin_amdgcn_permlane32_swap(__float_as_uint(ss), __float_as_uint(ss), false, false); ss = __uint_as_float(rr[0]) + __uint_as_float(rr[1]); } \
        const float rstd = 1.0f / sqrtf(ss * (1.f / DQK) + EPS); \
        constexpr int NPLAIN = QPREP == 1 ? 8 : DQK / 16; \
_Pragma("unroll") \
        for (int d0 = 0; d0 < NPLAIN; ++d0) { const v4u w = __builtin_bit_cast(v4u, qr[d0]); const LAS float* g = gq + d0 * 16; v4u o_; \
            o_.x = pk2(bflo(w.x) * rstd * g[0], bfhi(w.x) * rstd * g[1]); o_.y = pk2(bflo(w.y) * rstd * g[2], bfhi(w.y) * rstd * g[3]); \
            o_.z = pk2(bflo(w.z) * rstd * g[4], bfhi(w.z) * rstd * g[5]); o_.w = pk2(bflo(w.w) * rstd * g[6], bfhi(w.w) * rstd * g[7]); qr[d0] = __builtin_bit_cast(bf16x8, o_); } \
        if constexpr (QPREP == 1) { \
            const float pos = (float)qpos; \
_Pragma("unroll") \
            for (int dd = 0; dd < 2; ++dd) { const v4u w1 = __builtin_bit_cast(v4u, qr[8 + dd]), w2 = __builtin_bit_cast(v4u, qr[10 + dd]); \
                float x1[8] = {bflo(w1.x), bfhi(w1.x), bflo(w1.y), bfhi(w1.y), bflo(w1.z), bfhi(w1.z), bflo(w1.w), bfhi(w1.w)}; \
                float x2[8] = {bflo(w2.x), bfhi(w2.x), bflo(w2.y), bfhi(w2.y), bflo(w2.z), bfhi(w2.z), bflo(w2.w), bfhi(w2.w)}; \
                const LAS float* g1 = gq + (8 + dd) * 16; const LAS float* g2 = gq + (10 + dd) * 16; \
_Pragma("unroll") \
                for (int e = 0; e < 8; ++e) { const int fi = dd * 16 + hi * 8 + e; \
                    const float invf = __builtin_amdgcn_exp2f(-(float)fi * (13.287712379549449f / 32.0f)); \
                    float rev = pos * invf * 0.15915494309189535f; rev -= rintf(rev); const float sn = __builtin_amdgcn_sinf(rev), cs = __builtin_amdgcn_cosf(rev); \
                    const float a = x1[e] * rstd * g1[e], b = x2[e] * rstd * g2[e]; x1[e] = a * cs - b * sn; x2[e] = b * cs + a * sn; } \
                v4u o1, o2; o1.x = pk2(x1[0], x1[1]); o1.y = pk2(x1[2], x1[3]); o1.z = pk2(x1[4], x1[5]); o1.w = pk2(x1[6], x1[7]); \
                o2.x = pk2(x2[0], x2[1]); o2.y = pk2(x2[2], x2[3]); o2.z = pk2(x2[4], x2[5]); o2.w = pk2(x2[6], x2[7]); \
                qr[8 + dd] = __builtin_bit_cast(bf16x8, o1); qr[10 + dd] = __builtin_bit_cast(bf16x8, o2); } \
        } \
    } \
    __builtin_amdgcn_sched_barrier(0); } while (0)
    __builtin_amdgcn_sched_barrier(0);
    const __amdgpu_buffer_rsrc_t rsK = __builtin_amdgcn_make_buffer_rsrc((void*)Kh, (short)0, 0x7FFFFFFF, 0x00020000);
    const __amdgpu_buffer_rsrc_t rsV = __builtin_amdgcn_make_buffer_rsrc((void*)Vh, (short)0, 0x7FFFFFFF, 0x00020000);
    const unsigned ldkb = (unsigned)LDK * 2u, ldvb = (unsigned)LDV * 2u;
    unsigned kvo[NKI], vvo[NVI];
#pragma unroll
    for (int i = 0; i < NKI; ++i) { const int p = (wid * NKI + i) * 1024 + lane * 16, row = p / KROW, ch = (p % KROW) >> 4; kvo[i] = (unsigned)row * ldkb + (unsigned)((ch ^ ((row >> 1) & 7)) << 4); }
#pragma unroll
    for (int i = 0; i < NVI; ++i) { const int p = (wid * NVI + i) * 1024 + lane * 16, sub = p >> 9, within = p & 511, kk = (sub >> 2) * 8 + (within >> 6);
        const int key = (kk & ~0xC) | ((kk & 4) << 1) | ((kk & 8) >> 1), c = (sub & 3) * 32 + ((within & 63) >> 1); vvo[i] = (unsigned)key * ldvb + (unsigned)c * 2u; }
#define DMA_K(slot, tile) do { if constexpr (!(ABL & 16)) _Pragma("unroll") for (int i = 0; i < NKI; ++i) \
    __builtin_amdgcn_raw_ptr_buffer_load_lds(rsK, (LAS void*)(K_lds + (slot) * SHM_K + (wid * NKI + i) * 1024), 16, (int)kvo[i], (int)((unsigned)(tile) * KVBLK * ldkb), 0, 0); } while (0)
#define DMA_V(slot, tile) do { if constexpr (!(ABL & 16)) _Pragma("unroll") for (int i = 0; i < NVI; ++i) \
    __builtin_amdgcn_raw_ptr_buffer_load_lds(rsV, (LAS void*)(V_lds + (slot) * SHM_V + (wid * NVI + i) * 1024), 16, (int)vvo[i], (int)((unsigned)(tile) * KVBLK * ldvb), 0, 0); } while (0)
#define BAR() do { if constexpr (!(ABL & 32)) __builtin_amdgcn_s_barrier(); asm volatile("" ::: "memory"); } while (0)
#define QKT(C0, C1, KP, RELB, NR) do { if constexpr (!(ABL & 8)) qkt<DQK, BIAS>(C0, C1, KP, qr, r32, hi); else { _Pragma("unroll") for (int r_ = 0; r_ < 16; ++r_) { C0[r_] = 0.f; C1[r_] = 0.f; } } } while (0)
#define PVALL(VB) do { if constexpr (!(ABL & 4)) pv_all(o, VB, pa0, pa1, pa2, pa3); } while (0)
#define QKT_V(C0, C1, KP, VB) do { if constexpr (!(ABL & 8)) qkt<DQK, BIAS, true>(C0, C1, KP, qr, r32, hi, VB, &vf); else { _Pragma("unroll") for (int r_ = 0; r_ < 16; ++r_) { C0[r_] = 0.f; C1[r_] = 0.f; } pv_pre(vf, VB); } } while (0)
#define PVALL_PRE(VB) do { if constexpr (!(ABL & 4)) pv_all_pre(o, VB, pa0, pa1, pa2, pa3, vf); } while (0)
#if FIXMAX
#define PSM(C0, C1, ALC, RELB, NR) do { if constexpr (!(ABL & 2)) partialSM<BIAS, (ABL & 1) != 0>(C0, C1, tabL + (RELB), NR); } while (0)
#define FSM(P0, P1, ALP) do { if constexpr (!(ABL & 2)) finishSM<(ABL & 1) != 0>(P0, P1, l_reg, pa0, pa1, pa2, pa3); else { pa0 = __builtin_bit_cast(bf16x8, (f32x4){P0[0], P0[1], P0[2], P0[3]}); pa1 = __builtin_bit_cast(bf16x8, (f32x4){P0[4], P0[5], P0[6], P0[7]}); pa2 = __builtin_bit_cast(bf16x8, (f32x4){P1[0], P1[1], P1[2], P1[3]}); pa3 = __builtin_bit_cast(bf16x8, (f32x4){P1[4], P1[5], P1[6], P1[7]}); } } while (0)
#else
#define PSM(C0, C1, ALC, RELB, NR) do { if constexpr (!(ABL & 2)) partialSM<BIAS, (ABL & 1) != 0>(C0, C1, m_reg, ALC, C, tabL, RELB, NR); } while (0)
#define FSM(P0, P1, ALP) do { if constexpr (!(ABL & 2)) finishSM<(ABL & 1) != 0>(P0, P1, ALP, l_reg, pa0, pa1, pa2, pa3); else { pa0 = __builtin_bit_cast(bf16x8, (f32x4){P0[0], P0[1], P0[2], P0[3]}); pa1 = __builtin_bit_cast(bf16x8, (f32x4){P0[4], P0[5], P0[6], P0[7]}); pa2 = __builtin_bit_cast(bf16x8, (f32x4){P1[0], P1[1], P1[2], P1[3]}); pa3 = __builtin_bit_cast(bf16x8, (f32x4){P1[4], P1[5], P1[6], P1[7]}); } } while (0)
#endif
#if FIXMAX
    float l_reg = 0.f; f32x16 o[4];
#else
    float m_reg = -1e30f, l_reg = 0.f; f32x16 o[4];
#endif
    const int vb0 = (int)(unsigned)(size_t)V_lds + v_rd_base(lane);
    const int relb0 = 192 + 4 * hi - qpos;
#if FIXMAX
#define RESC(a) do { } while (0)
#else
#define RESC(a) do { if (__any((a) < 1.f)) { if (hi == 0) al_l[r32] = (a); asm volatile("s_waitcnt lgkmcnt(0)" ::: "memory"); \
    _Pragma("unroll") for (int r = 0; r < 16; ++r) { const float a_ = al_l[crow(r, hi)]; _Pragma("unroll") for (int d = 0; d < 4; ++d) o[d][r] *= a_; } } } while (0)
#endif
#define NEAR(j) (((j) * KVBLK + 63 - qw0) > -91)
    f32x16 pA0, pA1, pB0, pB1; bf16x8 pa0, pa1, pa2, pa3;
#if !FIXMAX
    float alA = 1.f, alB = 1.f;
#endif
    int vs = 0;
    int j = 1;
    if constexpr (PIPE == 2) {
        const bool halfB = wid >= 4;
        DMA_K(0, 0); DMA_V(0, 0); DMA_K(1, 1); DMA_V(1, 1); DMA_K(2, 2);
        Q_LOAD_PREP();
#pragma unroll
        for (int d = 0; d < 4; ++d)
#pragma unroll
            for (int r = 0; r < 16; ++r) o[d][r] = 0.f;
        asm volatile("s_waitcnt vmcnt(0) lgkmcnt(0)" ::: "memory");
        BAR();
        QKT(pA0, pA1, K_lds, relb0, NEAR(0)); PSM(pA0, pA1, alA, relb0, NEAR(0)); RESC(alA); FSM(pA0, pA1, alA);
#define INC3(x) ((x) == 2 ? 0 : (x) + 1)
#define SYNC_ISSUE(k, ksl, vsl) do { asm volatile("s_waitcnt vmcnt(0)" ::: "memory"); BAR(); \
        if ((k) + 3 < NT) DMA_K(ksl, (k) + 3); if ((k) + 2 < NT) DMA_V(vsl, (k) + 2); } while (0)
        if (!halfB) SYNC_ISSUE(0, 0, 2);
        for (; j <= my_last; ++j) {
            const int ks_ = INC3(vs);
            s16x4 vf[8];
            QKT_V(pA0, pA1, K_lds + ks_ * SHM_K, vb0 + vs * SHM_V);
            PVALL_PRE(vb0 + vs * SHM_V);
            __builtin_amdgcn_sched_barrier(0);
            if (halfB) SYNC_ISSUE(j - 1, vs, INC3(ks_));
            __builtin_amdgcn_sched_barrier(0);
            PSM(pA0, pA1, alA, relb0 + j * KVBLK, NEAR(j)); RESC(alA); FSM(pA0, pA1, alA);
            __builtin_amdgcn_sched_barrier(0);
            if (!halfB) SYNC_ISSUE(j, ks_, vs);
            vs = ks_;
        }
        PVALL(vb0 + vs * SHM_V);
        { int ksl = halfB ? vs : INC3(vs);
          for (int k = halfB ? j - 1 : j; k < NT; ++k) { const int vsl = INC3(INC3(ksl)); SYNC_ISSUE(k, ksl, vsl); ksl = INC3(ksl); } }
#undef SYNC_ISSUE
#undef INC3
    } else if constexpr (PIPE == 1) {
        const bool halfB = wid >= 4;
        DMA_K(0, 0); DMA_V(0, 0); DMA_K(1, 1);
        Q_LOAD_PREP();
#pragma unroll
        for (int d = 0; d < 4; ++d)
#pragma unroll
            for (int r = 0; r < 16; ++r) o[d][r] = 0.f;
        if constexpr (NKI == 3) asm volatile("s_waitcnt vmcnt(3) lgkmcnt(0)" ::: "memory"); else asm volatile("s_waitcnt vmcnt(1) lgkmcnt(0)" ::: "memory");
        BAR();
        QKT(pA0, pA1, K_lds, relb0, NEAR(0)); PSM(pA0, pA1, alA, relb0, NEAR(0)); RESC(alA);
        asm volatile("s_waitcnt vmcnt(0)" ::: "memory"); BAR();
        DMA_K(0, 2); DMA_V(1, 1);
#define SYNC_ISSUE(j, KS) do { asm volatile("s_waitcnt vmcnt(0)" ::: "memory"); BAR(); \
        if ((j) + 2 < NT) DMA_K(KS, (j) + 2); if ((j) + 1 < NT) { int vn_ = vs + 2; vn_ = vn_ >= 3 ? vn_ - 3 : vn_; DMA_V(vn_, (j) + 1); } } while (0)
#define ITER(j, C0, C1, ALC, P0, P1, ALP, KS) do { \
        QKT(C0, C1, K_lds + (KS) * SHM_K, relb0 + (j) * KVBLK, NEAR(j)); \
        s16x4 vf[8]; pv_pre(vf, vb0 + vs * SHM_V); \
        FSM(P0, P1, ALP); \
        __builtin_amdgcn_sched_barrier(0); \
        if (halfB) SYNC_ISSUE(j, KS); \
        __builtin_amdgcn_sched_barrier(0); \
        PVALL_PRE(vb0 + vs * SHM_V); \
        PSM(C0, C1, ALC, relb0 + (j) * KVBLK, NEAR(j)); RESC(ALC); \
        __builtin_amdgcn_sched_barrier(0); \
        if (!halfB) SYNC_ISSUE(j, KS); \
        vs = vs == 2 ? 0 : vs + 1; } while (0)
        for (; j + 1 <= my_last; j += 2) {
            ITER(j, pB0, pB1, alB, pA0, pA1, alA, 1);
            ITER(j + 1, pA0, pA1, alA, pB0, pB1, alB, 0);
        }
        if (j <= my_last) {
            ITER(j, pB0, pB1, alB, pA0, pA1, alA, 1); ++j;
            FSM(pB0, pB1, alB); __builtin_amdgcn_sched_barrier(0); PVALL(vb0 + vs * SHM_V);
        } else {
            FSM(pA0, pA1, alA); __builtin_amdgcn_sched_barrier(0); PVALL(vb0 + vs * SHM_V);
        }
#undef ITER
        for (; j < NT; ++j) { SYNC_ISSUE(j, j & 1); vs = vs == 2 ? 0 : vs + 1; }
#undef SYNC_ISSUE
    } else {
        DMA_K(0, 0); DMA_V(0, 0); DMA_K(1, 1); DMA_V(1, 1);
        Q_LOAD_PREP();
#pragma unroll
        for (int d = 0; d < 4; ++d)
#pragma unroll
            for (int r = 0; r < 16; ++r) o[d][r] = 0.f;
        if constexpr (NKI == 3) asm volatile("s_waitcnt vmcnt(5) lgkmcnt(0)" ::: "memory"); else asm volatile("s_waitcnt vmcnt(3) lgkmcnt(0)" ::: "memory");
        BAR();
        QKT(pA0, pA1, K_lds, relb0, NEAR(0)); PSM(pA0, pA1, alA, relb0, NEAR(0)); RESC(alA);
        FSM(pA0, pA1, alA); __builtin_amdgcn_sched_barrier(0); PVALL(vb0);
        asm volatile("s_waitcnt vmcnt(0)" ::: "memory"); BAR();
#define ISSUE_NEXT(j, KSN) do { int vn_ = vs + 2; vn_ = vn_ >= 3 ? vn_ - 3 : vn_; DMA_K(KSN, (j) + 1); DMA_V(vn_, (j) + 1); } while (0)
#define END_ITER() do { asm volatile("s_waitcnt vmcnt(0)" ::: "memory"); BAR(); vs = vs == 2 ? 0 : vs + 1; } while (0)
        for (; j <= my_last; ++j) {
            if (j + 1 < NT) ISSUE_NEXT(j, (j + 1) & 1);
            __builtin_amdgcn_sched_barrier(0);
            QKT(pA0, pA1, K_lds + (j & 1) * SHM_K, relb0 + j * KVBLK, NEAR(j));
            PSM(pA0, pA1, alA, relb0 + j * KVBLK, NEAR(j)); RESC(alA);
            FSM(pA0, pA1, alA);
            __builtin_amdgcn_sched_barrier(0);
            { int vc = vs + 1; vc = vc == 3 ? 0 : vc; PVALL(vb0 + vc * SHM_V); }
            END_ITER();
        }
        for (; j < NT; ++j) { if (j + 1 < NT) ISSUE_NEXT(j, (j + 1) & 1); END_ITER(); }
#undef ISSUE_NEXT
#undef END_ITER
    }
    BAR();
#undef DMA_K
#undef DMA_V
#undef RESC
#undef NEAR
#if FIXMAX
    { auto rr = __builtin_amdgcn_permlane32_swap(__float_as_uint(l_reg), __float_as_uint(l_reg), false, false); l_reg = __uint_as_float(rr[0]) + __uint_as_float(rr[1]); }
#endif
    if (hi == 0) li_l[r32] = l_reg;
    asm volatile("s_waitcnt lgkmcnt(0)" ::: "memory");
    float rli[16];
#pragma unroll
    for (int r = 0; r < 16; ++r) rli[r] = __builtin_amdgcn_rcpf(li_l[crow(r, hi)]);
    if constexpr (EPI == 2) {
        float gl[4];
#pragma unroll
        for (int d0 = 0; d0 < 4; ++d0) gl[d0] = subg[d0 * 32 + r32] * post;
#pragma unroll
        for (int r = 0; r < 16; ++r) { const int orow = wid * 32 + crow(r, hi);
            float dv[4]; float ss = 0.f;
#pragma unroll
            for (int d0 = 0; d0 < 4; ++d0) { dv[d0] = Of[(size_t)orow * LDOF + d0 * 32 + r32] - lam * (o[d0][r] * rli[r]); ss += dv[d0] * dv[d0]; }
            ss += __shfl_xor(ss, 1); ss += __shfl_xor(ss, 2); ss += __shfl_xor(ss, 4); ss += __shfl_xor(ss, 8); ss += __shfl_xor(ss, 16);
            const float rstd = 1.0f / sqrtf(ss * (1.f / 128.f) + EPS);
#pragma unroll
            for (int d0 = 0; d0 < 4; ++d0) Ob[(size_t)orow * LDO + d0 * 32 + r32] = (bf16)f2bf(dv[d0] * rstd * gl[d0]); }
    } else {
#pragma unroll
    for (int r = 0; r < 16; ++r) { const int orow = wid * 32 + crow(r, hi);
#pragma unroll
        for (int d0 = 0; d0 < 4; ++d0) { const float v = o[d0][r] * rli[r];
            if (EPI == 1) Of[(size_t)orow * LDO + d0 * 32 + r32] = v; else Ob[(size_t)orow * LDO + d0 * 32 + r32] = (bf16)f2bf(v); } }
    }
#undef BAR
#undef QKT
#undef PVALL
#undef QKT_V
#undef PVALL_PRE
#undef PSM
#undef FSM
#undef Q_LOAD_PREP
}
}

constexpr int NWAVES = 8;
struct Args { const float* in[25]; float* out; unsigned char* ws; int ph_lo, ph_hi; };
struct Frame {
    LAS unsigned char* lds;
    int tid, lane, wave, G, gw, NGW;
    const float* const* in; float* out; unsigned char* ws; unsigned* ctl;
};

__device__ __forceinline__ void p0_transpose_item(const float* W, int K, int N, bf16* WT, LAS float* scr, int item, int lane) {
    const int nblk = N / 32, kb = item / nblk, nb = item % nblk, k0 = 64 * kb, n0 = 32 * nb;
#pragma unroll 8
    for (int i = 0; i < 32; ++i) { const int kk = 2 * i + (lane >> 5); scr[kk * 33 + (lane & 31)] = W[(size_t)(k0 + kk) * N + n0 + (lane & 31)]; }
    LDS_WAIT(); asm volatile("" ::: "memory");
    const int c = lane & 7;
#pragma unroll
    for (int j = 0; j < 4; ++j) { const int n = (lane >> 3) + 8 * j; const LAS float* s = scr + (8 * c) * 33 + n;
        v4u o; o.x = pk2(s[0 * 33], s[1 * 33]); o.y = pk2(s[2 * 33], s[3 * 33]); o.z = pk2(s[4 * 33], s[5 * 33]); o.w = pk2(s[6 * 33], s[7 * 33]);
        *(v4u*)(WT + (size_t)(n0 + n) * K + k0 + 8 * c) = o; }
    LDS_WAIT(); asm volatile("" ::: "memory");
}
__device__ __forceinline__ unsigned pk4_fp8s(float a, float b, float c, float d) {
    a = __builtin_amdgcn_fmed3f(a, 448.0f, -448.0f); b = __builtin_amdgcn_fmed3f(b, 448.0f, -448.0f); c = __builtin_amdgcn_fmed3f(c, 448.0f, -448.0f); d = __builtin_amdgcn_fmed3f(d, 448.0f, -448.0f);
    int w = __builtin_amdgcn_cvt_pk_fp8_f32(a, b, 0, false); w = __builtin_amdgcn_cvt_pk_fp8_f32(c, d, w, true); return (unsigned)w;
}
constexpr float WSCALE = 64.0f, WSCALE_INV = 1.0f / 64.0f;
constexpr int CONV_GU_ITEMS = NE * (DM / 128) * (2 * DFF / 64), CONV_DN_ITEMS = NE * (DFF / 128) * (DM / 64), CONV_WAVE_ITEMS = CONV_GU_ITEMS + CONV_DN_ITEMS, CONV_BLOCK_ITEMS = CONV_WAVE_ITEMS / 8;
__device__ __forceinline__ void conv_item_fp8(const float* W, int N, unsigned char* WT, int K, int k0, int n0, LAS unsigned char* tile, int lane) {
    const int g = lane >> 4, c = lane & 15;
    const float* src = W + (size_t)(k0 + 4 * g) * N + n0 + 4 * c;
    LAS unsigned char* wbase = tile + (4 * c) * 128;
    const int swz = 4 * (c & 7);
#pragma unroll 1
    for (int half = 0; half < 2; ++half) {
        f32x4 v[4][4];
#pragma unroll
        for (int q = 0; q < 4; ++q)
#pragma unroll
            for (int i = 0; i < 4; ++i) v[q][i] = __builtin_nontemporal_load((const f32x4*)(src + (size_t)(64 * half + 16 * q + i) * N));
#pragma unroll
        for (int q = 0; q < 4; ++q) { const int kq = (16 * half + 4 * q + g) ^ swz;
#pragma unroll
            for (int j = 0; j < 4; ++j) *(LAS unsigned*)(wbase + j * 128 + kq * 4) = pk4_fp8s(v[q][0][j] * WSCALE, v[q][1][j] * WSCALE, v[q][2][j] * WSCALE, v[q][3][j] * WSCALE); }
    }
    LDS_WAIT(); asm volatile("" ::: "memory");
    const int m = lane & 7;
#pragma unroll
    for (int it = 0; it < 8; ++it) { const int row = (lane >> 3) + 8 * it;
        const v4u x = *(const LAS v4u*)(tile + row * 128 + ((m ^ ((row >> 2) & 7)) * 16));
        st16_wt(WT + (size_t)(n0 + row) * K + k0 + m * 16, x); }
    LDS_WAIT(); asm volatile("" ::: "memory");
}
__device__ __forceinline__ void conv_block_item(Frame& F, int bitem) {
    int lane = F.lane; asm volatile("" : "+v"(lane));
    int id = bitem * 8 + F.wave;
    LAS unsigned char* tile = F.lds + RING_OFF + F.wave * 8192;
    if (id < CONV_GU_ITEMS) { const int e = id >> 10, r = id & 1023, kb = r >> 6, nb = r & 63;
        conv_item_fp8(F.in[20] + (size_t)e * DM * 2 * DFF, 2 * DFF, F.ws + WS_WGU + (size_t)e * 2 * DFF * DM, DM, kb * 128, nb * 64, tile, lane); }
    else { id -= CONV_GU_ITEMS; const int e = id >> 9, r = id & 511, kb = r >> 5, nb = r & 31;
        conv_item_fp8(F.in[22] + (size_t)e * DFF * DM, DM, F.ws + WS_WDN + (size_t)e * DM * DFF, DFF, kb * 128, nb * 64, tile, lane); }
}
__device__ __forceinline__ bool conv_claim(Frame& F, int n) {
    volatile LAS int* ubox = (volatile LAS int*)(F.lds + MISC_UNIT);
    if (F.tid == 0) ubox[1] = (int)__hip_atomic_fetch_add(F.ctl + CW_CONV, (unsigned)n, __ATOMIC_RELAXED, __HIP_MEMORY_SCOPE_AGENT);
    __syncthreads();
    const int b0 = ubox[1];
    __syncthreads();
    for (int b = b0; b < b0 + n && b < CONV_BLOCK_ITEMS; ++b) conv_block_item(F, b);
    return b0 + n < CONV_BLOCK_ITEMS;
}
__device__ __forceinline__ void rms_row_to_bf16(const float* xrow, const float* w, bf16* orow, int lane) {
    const f32x4* xr = (const f32x4*)xrow + lane; const f32x4* wr = (const f32x4*)w + lane;
    f32x4 v[8]; float s = 0.f;
#pragma unroll
    for (int j = 0; j < 8; ++j) { v[j] = xr[64 * j]; s += (v[j].x * v[j].x + v[j].y * v[j].y) + (v[j].z * v[j].z + v[j].w * v[j].w); }
    const float rstd = 1.0f / sqrtf(wave_sum(s) * (1.f / DM) + EPS);
    v2u* o8 = (v2u*)orow + lane;
#pragma unroll
    for (int j = 0; j < 8; ++j) { const f32x4 g = wr[64 * j]; v2u o; o.x = pk2(v[j].x * rstd * g.x, v[j].y * rstd * g.y); o.y = pk2(v[j].z * rstd * g.z, v[j].w * rstd * g.w); o8[64 * j] = o; }
}

__device__ __forceinline__ void rms_row_to_fp8(const float* xrow, const float* w, unsigned char* orow, int lane) {
    const f32x4* xr = (const f32x4*)xrow + lane; const f32x4* wr = (const f32x4*)w + lane;
    f32x4 v[8]; float s = 0.f;
#pragma unroll
    for (int j = 0; j < 8; ++j) { v[j] = xr[64 * j]; s += (v[j].x * v[j].x + v[j].y * v[j].y) + (v[j].z * v[j].z + v[j].w * v[j].w); }
    const float rstd = 1.0f / sqrtf(wave_sum(s) * (1.f / DM) + EPS);
    unsigned* o4 = (unsigned*)orow + lane;
#pragma unroll
    for (int j = 0; j < 8; ++j) { const f32x4 g = wr[64 * j]; o4[64 * j] = pk4_fp8s(v[j].x * rstd * g.x, v[j].y * rstd * g.y, v[j].z * rstd * g.z, v[j].w * rstd * g.w); }
}
#ifndef INPROJ_FP8
#define INPROJ_FP8 0
#endif
__device__ __forceinline__ void p0_prologue(Frame& F) {
    LAS float* scr = (LAS float*)(F.lds + RING_OFF + F.wave * 16384);
    const float* w_in = F.in[2]; const float* w_uq = F.in[4]; const float* w_ukv = F.in[6]; const float* w_o = F.in[16];
    bf16* WIN = (bf16*)(F.ws + WS_WIN); bf16* WUQ = (bf16*)(F.ws + WS_WUQ); bf16* WUKV = (bf16*)(F.ws + WS_WUKV); bf16* WO = (bf16*)(F.ws + WS_WO);
    constexpr int I_IN = (DM / 64) * (INW / 32), I_UQ = (QRANK / 64) * (MH * QKD / 32), I_UKV = (KVRANK / 64) * (MH * 256 / 32), I_O = (DM / 64) * (DM / 32);
#if INPROJ_FP8
    constexpr int I_IN8 = (DM / 128) * (INW / 64);
    constexpr int NITEMS = I_IN8 + I_UQ + I_UKV + I_O;
    for (int it = F.gw; it < NITEMS; it += F.NGW) {
        int r = it;
        if (r < I_IN8) { conv_item_fp8(w_in, INW, F.ws + WS_WIN, DM, (r / (INW / 64)) * 128, (r % (INW / 64)) * 64, F.lds + RING_OFF + F.wave * 16384, F.lane); continue; } r -= I_IN8;
#else
    constexpr int NITEMS = I_IN + I_UQ + I_UKV + I_O;
    for (int it = F.gw; it < NITEMS; it += F.NGW) {
        int r = it;
        if (r < I_IN) { p0_transpose_item(w_in, DM, INW, WIN, scr, r, F.lane); continue; } r -= I_IN;
#endif
        if (r < I_UQ) { p0_transpose_item(w_uq, QRANK, MH * QKD, WUQ, scr, r, F.lane); continue; } r -= I_UQ;
        if (r < I_UKV) { p0_transpose_item(w_ukv, KVRANK, MH * 256, WUKV, scr, r, F.lane); continue; } r -= I_UKV;
        p0_transpose_item(w_o, DM, DM, WO, scr, r, F.lane);
    }
    { v4u* z = (v4u*)((unsigned char*)WIN + (size_t)INW * DM * (INPROJ_FP8 ? 1 : 2)); const int n16 = (INWP - INW) * DM * (INPROJ_FP8 ? 1 : 2) / 16;
      for (int i = blockIdx.x * 512 + F.tid; i < n16; i += F.G * 512) z[i] = (v4u){0u, 0u, 0u, 0u}; }
    { const float* x = F.in[0]; const float* w = F.in[1]; bf16* H = (bf16*)(F.ws + WS_H);
      const int lane = F.lane; f32x4 g[8], cur[8], nxt[8];
#pragma unroll
      for (int j = 0; j < 8; ++j) g[j] = ((const f32x4*)w + lane)[64 * j];
      int m = F.gw;
      if (m < NTOK) {
#pragma unroll
          for (int j = 0; j < 8; ++j) cur[j] = ((const f32x4*)(x + (size_t)m * DM) + lane)[64 * j]; }
      for (; m < NTOK; m += F.NGW) {
          const int mn = m + F.NGW;
          if (mn < NTOK) {
#pragma unroll
              for (int j = 0; j < 8; ++j) nxt[j] = ((const f32x4*)(x + (size_t)mn * DM) + lane)[64 * j]; }
          float sq = 0.f;
#pragma unroll
          for (int j = 0; j < 8; ++j) sq += (cur[j].x * cur[j].x + cur[j].y * cur[j].y) + (cur[j].z * cur[j].z + cur[j].w * cur[j].w);
          const float rstd = 1.0f / sqrtf(wave_sum(sq) * (1.f / DM) + EPS);
          v2u* o8 = (v2u*)(H + (size_t)m * DM) + lane;
#pragma unroll
          for (int j = 0; j < 8; ++j) { v2u o; o.x = pk2(cur[j].x * rstd * g[j].x, cur[j].y * rstd * g[j].y); o.y = pk2(cur[j].z * rstd * g[j].z, cur[j].w * rstd * g[j].w); o8[64 * j] = o; }
#pragma unroll
          for (int j = 0; j < 8; ++j) cur[j] = nxt[j];
      } }
    { const float* fw = F.in[17]; const float* rw = F.in[18]; float* RW = (float*)(F.ws + WS_RW);
      for (int i = blockIdx.x * 512 + F.tid; i < DM * NE; i += F.G * 512) RW[i] = fw[i >> 5] * rw[i]; }
}

__device__ __forceinline__ void unpack8(const v4u w, float (&f)[8]) { f[0] = bflo(w.x); f[1] = bfhi(w.x); f[2] = bflo(w.y); f[3] = bfhi(w.y); f[4] = bflo(w.z); f[5] = bfhi(w.z); f[6] = bflo(w.w); f[7] = bfhi(w.w); }
__device__ __forceinline__ v4u pack8(const float (&f)[8]) { v4u w; w.x = pk2(f[0], f[1]); w.y = pk2(f[2], f[3]); w.z = pk2(f[4], f[5]); w.w = pk2(f[6], f[7]); return w; }
__device__ __forceinline__ void p2_prep1(Frame& F) {
    const bf16* PROJ = (const bf16*)(F.ws + WS_PROJ);
    bf16* AQ = (bf16*)(F.ws + WS_AQ); bf16* AKV = (bf16*)(F.ws + WS_AKV); bf16* DQN = (bf16*)(F.ws + WS_DQN); bf16* DKN = (bf16*)(F.ws + WS_DKN);
    const float* qaw = F.in[3]; const float* kvaw = F.in[5]; const float* dqw = F.in[9]; const float* dkw = F.in[10];
    const int lane = F.lane;
    const bool actq = lane < 48, actkv = lane < 32;
    float gqa[8], gkva[8], gdq[8], gdk[8];
#pragma unroll
    for (int i = 0; i < 8; ++i) { gqa[i] = qaw[(actq ? lane : 0) * 8 + i]; gkva[i] = kvaw[(actkv ? lane : 0) * 8 + i]; gdq[i] = 0.f; gdk[i] = dkw[(lane & 7) * 8 + i]; }
#define P2_LOAD(T, R) do { const bf16* row_ = PROJ + (size_t)(T) * INWP; \
        R[0] = actq ? *(const v4u*)(row_ + C_CQ + lane * 8) : (v4u){0u, 0u, 0u, 0u}; R[1] = actkv ? *(const v4u*)(row_ + C_CKV + lane * 8) : (v4u){0u, 0u, 0u, 0u}; \
        R[2] = lane < 8 ? *(const v4u*)(row_ + C_KR + lane * 8) : (v4u){0u, 0u, 0u, 0u}; R[4] = *(const v4u*)(row_ + C_DK + lane * 8); R[5] = *(const v4u*)(row_ + C_DK + 512 + lane * 8); } while (0)
    v4u cur[6], nxt[6];
    int t = F.gw;
    if (t < NTOK) P2_LOAD(t, cur);
    for (; t < NTOK; t += F.NGW) {
        const int tn = t + F.NGW;
        if (tn < NTOK) P2_LOAD(tn, nxt);
        { float f[8]; unpack8(cur[0], f); float s = 0.f;
#pragma unroll
          for (int i = 0; i < 8; ++i) s += f[i] * f[i];
          const float rstd = 1.0f / sqrtf(wave_sum(s) * (1.f / QRANK) + EPS);
          if (actq) {
#pragma unroll
            for (int i = 0; i < 8; ++i) f[i] = f[i] * rstd * gqa[i];
            st16_wt(AQ + (size_t)t * QRANK + lane * 8, pack8(f)); } }
        { float f[8]; unpack8(cur[1], f); float s = 0.f;
#pragma unroll
          for (int i = 0; i < 8; ++i) s += f[i] * f[i];
          const float rstd = 1.0f / sqrtf(wave_sum(s) * (1.f / KVRANK) + EPS);
          if (actkv) {
#pragma unroll
            for (int i = 0; i < 8; ++i) f[i] = f[i] * rstd * gkva[i];
            st16_wt(AKV + (size_t)t * KVRANK + lane * 8, pack8(f)); } }
        { float f[8]; unpack8(cur[2], f); float s = 0.f;
#pragma unroll
          for (int i = 0; i < 8; ++i) s += f[i] * f[i];
          s += __shfl_xor(s, 1); s += __shfl_xor(s, 2); s += __shfl_xor(s, 4);
          if (lane == 0) ((float*)(F.ws + WS_DQN))[t] = s; }
#pragma unroll
        for (int w4 = 2; w4 < 4; ++w4) { const int which = w4 >> 1, half = w4 & 1;
            float f[8]; unpack8(cur[2 + w4], f); float s = 0.f;
#pragma unroll
            for (int i = 0; i < 8; ++i) s += f[i] * f[i];
            s += __shfl_xor(s, 1); s += __shfl_xor(s, 2); s += __shfl_xor(s, 4);
            const float rstd = 1.0f / sqrtf(s * (1.f / DHD) + EPS);
#pragma unroll
            for (int i = 0; i < 8; ++i) f[i] = f[i] * rstd * (which ? gdk[i] : gdq[i]);
            st16_wt((which ? DKN : DQN) + (size_t)t * 1024 + (half * 64 + lane) * 8, pack8(f)); }
#pragma unroll
        for (int i = 0; i < 6; ++i) cur[i] = nxt[i];
    }
#undef P2_LOAD
}

__device__ __forceinline__ void p4_prep2(Frame& F) {
    const bf16* PROJ = (const bf16*)(F.ws + WS_PROJ); const bf16* QF = (const bf16*)(F.ws + WS_QF); const bf16* KVF = (const bf16*)(F.ws + WS_KVF);
    bf16* QM = (bf16*)(F.ws + WS_QM); bf16* KM = (bf16*)(F.ws + WS_KM);
    const float* qnw = F.in[7]; const float* knw = F.in[8];
    const int lane = F.lane, l32 = lane & 31, sub = lane >> 5;
    const int m = l32 - 16;
    float gq[8], gk[8];
#pragma unroll
    for (int i = 0; i < 8; ++i) { const int idx = l32 < 16 ? l32 * 8 + i : (l32 < 24 ? (i < 4 ? NOPE + 4 * m + i : NOPE + 32 + 4 * m + (i - 4)) : 0); gq[i] = qnw[idx] * (0.07216878364870322f * LOG2E); gk[i] = knw[idx]; }
    float invf[4];
#pragma unroll
    for (int i = 0; i < 4; ++i) invf[i] = __builtin_amdgcn_exp2f(-(float)(4 * (m & 7) + i) * (13.287712379549449f / 32.0f));
    for (int t = F.gw; t < NTOK; t += F.NGW) {
        const int pos = t & (SEQ - 1);
        v4u raw[8];
#pragma unroll
        for (int it = 4; it < 8; ++it) { const int which = it >> 2, h = ((it & 3) << 1) + sub;
            if (l32 < 16) { const bf16* src = which ? (KVF + (size_t)t * 2048 + h * 256 + l32 * 8) : (QF + (size_t)t * 1536 + h * QKD + l32 * 8); raw[it] = *(const v4u*)src; }
            else if (l32 < 24) { const bf16* src = which ? (PROJ + (size_t)t * INWP + C_KR) : (QF + (size_t)t * 1536 + h * QKD + NOPE);
                const v2u a = *(const v2u*)(src + 4 * m), b = *(const v2u*)(src + 32 + 4 * m); raw[it] = (v4u){a.x, a.y, b.x, b.y}; }
            else raw[it] = (v4u){0u, 0u, 0u, 0u}; }
        float sn[4], cs[4];
#pragma unroll
        for (int i = 0; i < 4; ++i) { const float ang = (float)pos * invf[i]; float rev = ang * 0.15915494309189535f; rev -= rintf(rev); sn[i] = __builtin_amdgcn_sinf(rev); cs[i] = __builtin_amdgcn_cosf(rev); }
#pragma unroll
        for (int it = 4; it < 8; ++it) { const int which = it >> 2, h = ((it & 3) << 1) + sub;
            float f[8]; unpack8(raw[it], f);
            float s = 0.f;
#pragma unroll
            for (int i = 0; i < 8; ++i) s += f[i] * f[i];
            s += __shfl_xor(s, 1); s += __shfl_xor(s, 2); s += __shfl_xor(s, 4); s += __shfl_xor(s, 8); s += __shfl_xor(s, 16);
            const float rstd = 1.0f / sqrtf(s * (1.f / QKD) + EPS);
            bf16* dst = (which ? KM : QM) + (size_t)t * 1536 + h * QKD;
            if (l32 < 16) {
#pragma unroll
                for (int i = 0; i < 8; ++i) f[i] = f[i] * rstd * (which ? gk[i] : gq[i]);
                *(v4u*)(dst + l32 * 8) = pack8(f);
            } else if (l32 < 24) { float o1[4], o2[4];
#pragma unroll
                for (int i = 0; i < 4; ++i) { const float x1 = f[i] * rstd * (which ? gk[i] : gq[i]), x2 = f[4 + i] * rstd * (which ? gk[4 + i] : gq[4 + i]);
                    o1[i] = x1 * cs[i] - x2 * sn[i]; o2[i] = x2 * cs[i] + x1 * sn[i]; }
                v2u a, b; a.x = pk2(o1[0], o1[1]); a.y = pk2(o1[2], o1[3]); b.x = pk2(o2[0], o2[1]); b.y = pk2(o2[2], o2[3]);
                *(v2u*)(dst + NOPE + 4 * m) = a; *(v2u*)(dst + NOPE + 32 + 4 * m) = b;
            }
        }
    }
}

__device__ __forceinline__ int t5_bucket(int rel) {
    const int n = rel < 0 ? -rel : rel;
    int b = n < 8 ? n : (n < 12 ? 8 : (n < 16 ? 9 : (n < 23 ? 10 : (n < 32 ? 11 : (n < 46 ? 12 : (n < 64 ? 13 : (n < 91 ? 14 : 15)))))));
    return b + (rel > 0 ? 16 : 0);
}
__device__ __forceinline__ void p5_attention(Frame& F, int rep = 0) {
    const bf16* QM = (const bf16*)(F.ws + WS_QM); const bf16* KM = (const bf16*)(F.ws + WS_KM); const bf16* KVF = (const bf16*)(F.ws + WS_KVF);
    const bf16* DQN = (const bf16*)(F.ws + WS_DQN); const bf16* DKN = (const bf16*)(F.ws + WS_DKN); const bf16* PROJ = (const bf16*)(F.ws + WS_PROJ);
    float* OD = (float*)(F.ws + WS_OD); bf16* Y = (bf16*)(F.ws + WS_Y);
    const float* rel_bias = F.in[24];
    volatile LAS int* ubox = (volatile LAS int*)(F.lds + MISC_UNIT);
    LAS float* tabL = (LAS float*)(F.lds + att::OFF_TAB);
    const int myx = (int)(xb_xcc_id() & 7u);
    if (F.tid < 256) ((LAS float*)(F.lds + att::OFF_GQ))[F.tid] = F.tid < 192 ? F.in[7][F.tid] * (0.07216878364870322f * LOG2E) : F.in[9][F.tid - 192] * (0.125f * LOG2E);
    __syncthreads();
    const bf16* QF = (const bf16*)(F.ws + WS_QF);
    float lam; const float post = 1.0f - (0.8f - 0.6f * 1.0f);
    { const float d1 = wave_sum(F.in[11][F.lane] * F.in[12][F.lane]), d2 = wave_sum(F.in[13][F.lane] * F.in[14][F.lane]); lam = expf(d1) - expf(d2) + (0.8f - 0.6f * 1.0f); }
    constexpr int COST_PER_ITEM = 950;
    int carry = 0; bool more = true;
    for (int k = 0; k < 8; ++k) {
        const int qx = (myx + k) & 7;
        for (;;) {
            if (F.tid == 0) ubox[0] = (int)__hip_atomic_fetch_add(F.ctl + CW_AQ + (rep * 8 + qx) * CW_AQ_STRIDE, 1u, __ATOMIC_RELAXED, __HIP_MEMORY_SCOPE_AGENT);
            __syncthreads();
            const int item = __builtin_amdgcn_readfirstlane(ubox[0]);
            __syncthreads();
            if (item >= 128) break;
            const int qb = 31 - item / 4, kk = item % 4;
#ifndef ATT_ABL
#define ATT_ABL 0
#endif
#ifndef ATT_PROBE_WHICH
#define ATT_PROBE_WHICH 3
#endif
            if (kk < 2) {
                const int s = qx * 2 + kk, b = s >> 3, h = s & 7; const size_t tok0 = (size_t)b * SEQ + (size_t)qb * 256, tokb = (size_t)b * SEQ;
                if (rep == 0) att::attn_unit<QKD, false, 0, 2, 0, 1>(QF + tok0 * 1536 + h * QKD, 1536, KM + tokb * 1536 + h * QKD, 1536, KVF + tokb * 2048 + h * 256 + 128, 2048,
                                                  qb * 256, 0.07216878364870322f * LOG2E, 0.f, nullptr, Y + tok0 * 2048 + h * VD, 2048, F.lds);
                else if (ATT_PROBE_WHICH & 1) att::attn_unit<QKD, false, 0, 2, ATT_ABL, 1>(QF + tok0 * 1536 + h * QKD, 1536, KM + tokb * 1536 + h * QKD, 1536, KVF + tokb * 2048 + h * 256 + 128, 2048,
                                                  qb * 256, 0.07216878364870322f * LOG2E, 0.f, nullptr, (bf16*)(F.ws + WS_XG) + tok0 * 2048 + h * VD, 2048, F.lds);
                carry += (qb + 1) * 320;
            } else {
                const int d = qx * 2 + (kk - 2), b = d >> 3, h = d & 7; const size_t tok0 = (size_t)b * SEQ + (size_t)qb * 256, tokb = (size_t)b * SEQ;
                if (F.tid < 256) tabL[F.tid] = (rel_bias[t5_bucket(F.tid - 192) * DH + h] - rel_bias[t5_bucket(-192) * DH + h]) * LOG2E;
                float* O0 = OD + tok0 * 1024 + h * 128;
                if (rep == 0) {
                    att::attn_unit<DHD, true, 1, 1, 0, 2>(PROJ + tok0 * INWP + C_DQ + h * 128, INWP, DKN + tokb * 1024 + h * 128, 1024, PROJ + tokb * INWP + C_DV + h * 128, INWP,
                                                qb * 256, 0.125f * LOG2E, 0.f, O0, nullptr, 1024, F.lds);
                    att::attn_unit<DHD, true, 2, 1, 0, 2>(PROJ + tok0 * INWP + C_DQ + h * 128 + 64, INWP, DKN + tokb * 1024 + h * 128 + 64, 1024, PROJ + tokb * INWP + C_DV + h * 128, INWP,
                                                qb * 256, 0.125f * LOG2E, 0.f, O0, Y + tok0 * 2048 + 1024 + h * 128, 2048, F.lds, lam, F.in[15], post, 1024);
                } else if (ATT_PROBE_WHICH & 2) { for (int c = 0; c < 2; ++c) att::attn_unit<DHD, true, 1, 1, ATT_ABL, 2>(PROJ + tok0 * INWP + C_DQ + h * 128 + c * 64, INWP, DKN + tokb * 1024 + h * 128 + c * 64, 1024, PROJ + tokb * INWP + C_DV + h * 128, INWP,
                                                qb * 256, 0.125f * LOG2E, 0.f, (float*)(F.ws + WS_XG) + ((size_t)c * NTOK + tok0) * 1024 + h * 128, nullptr, 1024, F.lds); }
                carry += (qb + 1) * 384;
            }
            if (rep == 0 && more && carry >= COST_PER_ITEM) { const int n = carry / COST_PER_ITEM; carry -= n * COST_PER_ITEM; more = conv_claim(F, n); }
        }
    }
    if (rep == 0) while (more) more = conv_claim(F, 1);
}

__device__ __forceinline__ void p6_diffcombine(Frame& F) {
    const float* OD = (const float*)(F.ws + WS_OD); bf16* Y = (bf16*)(F.ws + WS_Y);
    const float* lq1 = F.in[11]; const float* lk1 = F.in[12]; const float* lq2 = F.in[13]; const float* lk2 = F.in[14]; const float* sw = F.in[15];
    const int lane = F.lane;
    const float d1 = wave_sum(lq1[lane] * lk1[lane]), d2 = wave_sum(lq2[lane] * lk2[lane]);
    const float lambda_init = 0.8f - 0.6f * 1.0f;
    const float lam = expf(d1) - expf(d2) + lambda_init;
    const float post = 1.0f - lambda_init;
    const f32x4 g = *(const f32x4*)(sw + (lane & 31) * 4);
    f32x4 ca[4], cb[4], na[4], nb[4];
    int t = F.gw;
    if (t < NTOK) {
#pragma unroll
        for (int q = 0; q < 4; ++q) { ca[q] = *((const f32x4*)(OD + (size_t)t * 1024) + q * 64 + lane); cb[q] = *((const f32x4*)(OD + ((size_t)NTOK + t) * 1024) + q * 64 + lane); } }
    for (; t < NTOK; t += F.NGW) {
        const int tn = t + F.NGW;
        if (tn < NTOK) {
#pragma unroll
            for (int q = 0; q < 4; ++q) { na[q] = *((const f32x4*)(OD + (size_t)tn * 1024) + q * 64 + lane); nb[q] = *((const f32x4*)(OD + ((size_t)NTOK + tn) * 1024) + q * 64 + lane); } }
#pragma unroll
        for (int q = 0; q < 4; ++q) {
            const f32x4 o = ca[q] - lam * cb[q];
            float s = (o.x * o.x + o.y * o.y) + (o.z * o.z + o.w * o.w);
            s += __shfl_xor(s, 1); s += __shfl_xor(s, 2); s += __shfl_xor(s, 4); s += __shfl_xor(s, 8); s += __shfl_xor(s, 16);
            const float rstd = 1.0f / sqrtf(s * (1.f / 128.f) + EPS) * post;
            v2u w; w.x = pk2(o.x * rstd * g.x, o.y * rstd * g.y); w.y = pk2(o.z * rstd * g.z, o.w * rstd * g.w);
            *((v2u*)(Y + (size_t)t * 2048 + 1024) + q * 64 + lane) = w;
        }
#pragma unroll
        for (int q = 0; q < 4; ++q) { ca[q] = na[q]; cb[q] = nb[q]; }
    }
}

__device__ __forceinline__ void p8_router(Frame& F, int rep = 0) {
#if X1_BF16
    const bf16* X1 = (const bf16*)(F.ws + WS_XG);
#else
    const float* X1 = F.out;
#endif
    const float* RW = (const float*)(F.ws + WS_RW); const float* rb = F.in[19]; const float* fw = F.in[17];
    unsigned char* H2 = F.ws + WS_H2;
    int* asg_e = (int*)(F.ws + WS_ASG); int* asg_r = asg_e + NASG; float* asg_g = (float*)(asg_r + NASG);
    LAS float* red = (LAS float*)(F.lds + RING_OFF);
    LAS float* ssq = (LAS float*)(F.lds + RING_OFF + 32768);
    LAS float* lg = (LAS float*)(F.lds + RING_OFF + 32768 + 2048);
    LAS float* rs = (LAS float*)(F.lds + RING_OFF + 32768 + 2048 + 4352);
    LAS unsigned* lcnt = (LAS unsigned*)(F.lds + RING_OFF + 32768 + 2048 + 4352 + 128);
    LAS unsigned* lbase = lcnt + 32;
    const int lane = F.lane, w = F.wave, i = lane & 31, kh = lane >> 5;
    for (int unit = blockIdx.x; unit < NTOK / 32; unit += F.G) {
        const int tok0 = unit * 32;
        f32x16 acc;
#pragma unroll
        for (int r = 0; r < 16; ++r) acc[r] = 0.f;
        float sq = 0.f;
        const auto* xr = X1 + (size_t)(tok0 + i) * DM + w * 256 + 4 * kh;
        const float* rwp = RW + (size_t)(w * 256 + 4 * kh) * NE + i;
#pragma unroll 16
        for (int m = 0; m < 32; ++m) {
#if X1_BF16
            const v2u raw_ = *(const v2u*)(xr + 8 * m); const f32x4 a4 = {bflo(raw_.x), bfhi(raw_.x), bflo(raw_.y), bfhi(raw_.y)};
#else
            const f32x4 a4 = *(const f32x4*)(xr + 8 * m);
#endif
            sq += (a4.x * a4.x + a4.y * a4.y) + (a4.z * a4.z + a4.w * a4.w);
            const float* bp = rwp + (size_t)(8 * m) * NE;
            acc = __builtin_amdgcn_mfma_f32_32x32x2f32(a4.x, bp[0 * NE], acc, 0, 0, 0);
            acc = __builtin_amdgcn_mfma_f32_32x32x2f32(a4.y, bp[1 * NE], acc, 0, 0, 0);
            acc = __builtin_amdgcn_mfma_f32_32x32x2f32(a4.z, bp[2 * NE], acc, 0, 0, 0);
            acc = __builtin_amdgcn_mfma_f32_32x32x2f32(a4.w, bp[3 * NE], acc, 0, 0, 0);
        }
#pragma unroll
        for (int r = 0; r < 16; ++r) red[(w * 32 + ((r & 3) + 8 * (r >> 2) + 4 * kh)) * 32 + i] = acc[r];
        ssq[w * 64 + lane] = sq;
        __syncthreads();
        for (int idx = F.tid; idx < 1024; idx += 512) { float s = 0.f;
#pragma unroll
            for (int ww = 0; ww < 8; ++ww) s += red[ww * 1024 + idx];
            lg[(idx >> 5) * 33 + (idx & 31)] = s; }
        if (F.tid < 32) { float s = 0.f;
#pragma unroll
            for (int ww = 0; ww < 8; ++ww) s += ssq[ww * 64 + F.tid] + ssq[ww * 64 + 32 + F.tid];
            rs[F.tid] = 1.0f / sqrtf(s * (1.f / DM) + EPS); }
        __syncthreads();
        if (F.tid < 32) {
            const int t = tok0 + F.tid; const float rstd = rs[F.tid];
            float v[NE];
#pragma unroll
            for (int e = 0; e < NE; ++e) v[e] = rstd * lg[F.tid * 33 + e] + rb[e];
            int sel[TOPK]; float sv[TOPK];
#pragma unroll
            for (int k = 0; k < TOPK; ++k) { float best = -3.0e38f; int bi = 0;
#pragma unroll
                for (int e = 0; e < NE; ++e) { const bool tk = v[e] > best; best = tk ? v[e] : best; bi = tk ? e : bi; }
                sel[k] = bi; sv[k] = best;
#pragma unroll
                for (int e = 0; e < NE; ++e) v[e] = (e == bi) ? -3.0e38f : v[e]; }
            float den = 0.f, ex[TOPK];
#pragma unroll
            for (int k = 0; k < TOPK; ++k) { ex[k] = expf(sv[k] - sv[0]); den += ex[k]; }
            const float rden = 1.0f / den;
            lcnt[F.tid] = 0;
            LDS_WAIT(); asm volatile("" ::: "memory");
            int lr[TOPK];
#pragma unroll
            for (int k = 0; k < TOPK; ++k) lr[k] = (int)__hip_atomic_fetch_add((LAS unsigned*)lcnt + sel[k], 1u, __ATOMIC_RELAXED, __HIP_MEMORY_SCOPE_WORKGROUP);
            LDS_WAIT(); asm volatile("" ::: "memory");
            ((int*)(F.ws + WS_UCNT))[unit * NE + F.tid] = (int)((volatile LAS unsigned*)lcnt)[F.tid];
#pragma unroll
            for (int k = 0; k < TOPK; ++k) { asg_e[t * TOPK + k] = sel[k]; asg_r[t * TOPK + k] = lr[k]; asg_g[t * TOPK + k] = ex[k] * rden; }
        }
#pragma unroll 1
        for (int q = 0; q < 4; q += 2) { const int tl = w * 4 + q; const float rstd0 = rs[tl], rstd1 = rs[tl + 1];
#if X1_BF16
            const v2u* xa = (const v2u*)(X1 + (size_t)(tok0 + tl) * DM) + lane; const v2u* xb = xa + DM / 4;
#else
            const f32x4* xa = (const f32x4*)(X1 + (size_t)(tok0 + tl) * DM) + lane; const f32x4* xb = xa + DM / 4;
#endif
            const f32x4* wr4 = (const f32x4*)fw + lane;
            unsigned* oa = (unsigned*)(H2 + (size_t)(tok0 + tl) * DM) + lane; unsigned* ob = oa + DM / 4;
            f32x4 va[8], vb[8];
#pragma unroll
#if X1_BF16
            for (int j = 0; j < 8; ++j) { const v2u ra = xa[64 * j], rb_ = xb[64 * j]; va[j] = (f32x4){bflo(ra.x), bfhi(ra.x), bflo(ra.y), bfhi(ra.y)}; vb[j] = (f32x4){bflo(rb_.x), bfhi(rb_.x), bflo(rb_.y), bfhi(rb_.y)}; }
#else
            for (int j = 0; j < 8; ++j) { va[j] = xa[64 * j]; vb[j] = xb[64 * j]; }
#endif
#pragma unroll
            for (int j = 0; j < 8; ++j) { const f32x4 g = wr4[64 * j];
                oa[64 * j] = pk4_fp8s(va[j].x * rstd0 * g.x, va[j].y * rstd0 * g.y, va[j].z * rstd0 * g.z, va[j].w * rstd0 * g.w);
                ob[64 * j] = pk4_fp8s(vb[j].x * rstd1 * g.x, vb[j].y * rstd1 * g.y, vb[j].z * rstd1 * g.z, vb[j].w * rstd1 * g.w); } }
        __syncthreads();
    }
}

__device__ __forceinline__ int moe_tables(Frame& F) {
    LAS int* pads = (LAS int*)(F.lds + MISC_PADS); LAS int* cnts = (LAS int*)(F.lds + MISC_CNTS); LAS int* blke = (LAS int*)(F.lds + MISC_BLKE);
    __syncthreads();
    if (F.tid < NE) cnts[F.tid] = (int)__hip_atomic_load(F.ctl + CW_CNT + F.tid * CW_CNT_STRIDE, __ATOMIC_RELAXED, __HIP_MEMORY_SCOPE_AGENT);
    __syncthreads();
    if (F.tid == 0) { int acc = 0;
        for (int e = 0; e < NE; ++e) { pads[e] = acc; acc += ((cnts[e] + 255) >> 8) << 8; }
        pads[NE] = acc; }
    __syncthreads();
    if (F.tid < NBLK_MAX) { const int s0 = F.tid << 8; int e = 0;
#pragma unroll 8
        for (int k = 1; k < NE; ++k) e += (pads[k] <= s0) ? 1 : 0;
        blke[F.tid] = e; }
    __syncthreads();
    return pads[NE] >> 8;
}

__device__ __forceinline__ void p9_gather(Frame& F) {
    constexpr int NUNIT = NTOK / 32;
    const int* ucnt = (const int*)(F.ws + WS_UCNT);
    LAS int* ubase = (LAS int*)(F.lds + RING_OFF);
    LAS int* segtot = (LAS int*)(F.lds + RING_OFF + NUNIT * NE * 4);
    LAS int* pads = (LAS int*)(F.lds + MISC_PADS); LAS int* cnts = (LAS int*)(F.lds + MISC_CNTS); LAS int* blke = (LAS int*)(F.lds + MISC_BLKE);
    __syncthreads();
    { const int e = F.tid & 31, seg = F.tid >> 5;
      int run = 0;
#pragma unroll 8
      for (int u = 0; u < 32; ++u) { const int un = seg * 32 + u; const int c = ucnt[un * NE + e]; ubase[un * NE + e] = run; run += c; }
      segtot[seg * NE + e] = run; }
    __syncthreads();
    if (F.tid < NE) { int run = 0;
        for (int seg = 0; seg < 16; ++seg) { const int c = segtot[seg * NE + F.tid]; segtot[seg * NE + F.tid] = run; run += c; }
        cnts[F.tid] = run;
        if (blockIdx.x == 0) F.ctl[CW_CNT + F.tid * CW_CNT_STRIDE] = (unsigned)run; }
    __syncthreads();
    if (F.tid == 0) { int acc = 0;
        for (int e = 0; e < NE; ++e) { pads[e] = acc; acc += ((cnts[e] + 255) >> 8) << 8; }
        pads[NE] = acc; }
    __syncthreads();
    if (F.tid < NBLK_MAX) { const int s0 = F.tid << 8; int e = 0;
#pragma unroll 8
        for (int k = 1; k < NE; ++k) e += (pads[k] <= s0) ? 1 : 0;
        blke[F.tid] = e; }
    const int* asg_e = (const int*)(F.ws + WS_ASG); const int* asg_r = asg_e + NASG; int* asg_s = (int*)(asg_r + 2 * NASG);
    int* stok = (int*)(F.ws + WS_STOK);
    for (int a = blockIdx.x * 512 + F.tid; a < NASG; a += F.G * 512) {
        const int e = asg_e[a], un = a >> 7, slot = pads[e] + segtot[(un >> 5) * NE + e] + ubase[un * NE + e] + asg_r[a];
        stok[slot] = a >> 2; asg_s[a] = slot;
    }
    for (int idx = blockIdx.x * 512 + F.tid; idx < NE * 256; idx += F.G * 512) {
        const int e = idx >> 8, r = idx & 255, c = cnts[e], padded = ((c + 255) >> 8) << 8;
        if (r < padded - c) stok[pads[e] + c + r] = 0;
    }
    __syncthreads();
}

#ifndef YS_FP8
#define YS_FP8 1
#endif
__device__ __forceinline__ void unpack8_fp8(const v2u w, float (&f)[8]) {
    const auto a = __builtin_amdgcn_cvt_pk_f32_fp8((int)w.x, false), b = __builtin_amdgcn_cvt_pk_f32_fp8((int)w.x, true), c = __builtin_amdgcn_cvt_pk_f32_fp8((int)w.y, false), d = __builtin_amdgcn_cvt_pk_f32_fp8((int)w.y, true);
    f[0] = a[0]; f[1] = a[1]; f[2] = b[0]; f[3] = b[1]; f[4] = c[0]; f[5] = c[1]; f[6] = d[0]; f[7] = d[1];
}
__device__ __forceinline__ void p12_combine(Frame& F, bool dummy = false) {
    const int* asg_s = (const int*)(F.ws + WS_ASG) + 3 * NASG; const float* asg_g = (const float*)(F.ws + WS_ASG) + 2 * NASG;
    float* out = F.out; float* dst = dummy ? (float*)(F.ws + WS_OD) : F.out;
    const int lane = F.lane;
    for (int t = F.gw; t < NTOK; t += F.NGW) {
        int sl[TOPK]; float g[TOPK];
#pragma unroll
        for (int k = 0; k < TOPK; ++k) { sl[k] = asg_s[t * TOPK + k]; g[k] = asg_g[t * TOPK + k]; }
        f32x4 a0[4], a1[4]; v4u xb[4];
#if YS_FP8
        const unsigned char* YS = F.ws + WS_YS; v2u y[4][TOPK];
#else
        const bf16* YS = (const bf16*)(F.ws + WS_YS); v4u y[4][TOPK];
#endif
#pragma unroll
        for (int j = 0; j < 4; ++j) { const int ch = lane + 64 * j;
#if X1_BF16
            xb[j] = *(const v4u*)((const bf16*)(F.ws + WS_XG) + (size_t)t * DM + ch * 8);
#else
            { const f32x4* o = (const f32x4*)(out + (size_t)t * DM + ch * 8); a0[j] = o[0]; a1[j] = o[1]; }
#endif
#pragma unroll
            for (int k = 0; k < TOPK; ++k) {
#if YS_FP8
                y[j][k] = *(const v2u*)(YS + (size_t)sl[k] * DM + ch * 8);
#else
                y[j][k] = *(const v4u*)(YS + (size_t)sl[k] * DM + ch * 8);
#endif
            } }
#pragma unroll
        for (int j = 0; j < 4; ++j) { const int ch = lane + 64 * j; f32x4* od = (f32x4*)(dst + (size_t)t * DM + ch * 8);
#if X1_BF16
            { float f[8]; unpack8(xb[j], f); a0[j] = (f32x4){f[0], f[1], f[2], f[3]}; a1[j] = (f32x4){f[4], f[5], f[6], f[7]}; }
#endif
#pragma unroll
            for (int k = 0; k < TOPK; ++k) { float f[8];
#if YS_FP8
                unpack8_fp8(y[j][k], f);
#else
                unpack8(y[j][k], f);
#endif
                a0[j].x += g[k] * f[0]; a0[j].y += g[k] * f[1]; a0[j].z += g[k] * f[2]; a0[j].w += g[k] * f[3]; a1[j].x += g[k] * f[4]; a1[j].y += g[k] * f[5]; a1[j].z += g[k] * f[6]; a1[j].w += g[k] * f[7]; }
            od[0] = a0[j]; od[1] = a1[j]; }
    }
}

#ifndef MK_SINGLE
#define MK_SINGLE 1
#endif
constexpr int N_PHASES = 13;

__global__ void __launch_bounds__(NWAVES * 64, 2) mk_fwd(Args args) {
    extern __shared__ __attribute__((aligned(16))) unsigned char lds_raw[];
    Frame F;
    F.lds = (LAS unsigned char*)lds_raw;
    F.tid = threadIdx.x; F.lane = F.tid & 63; F.wave = __builtin_amdgcn_readfirstlane(F.tid >> 6);
    F.G = gridDim.x; F.gw = blockIdx.x * NWAVES + F.wave; F.NGW = F.G * NWAVES;
    F.in = args.in; F.out = args.out; F.ws = args.ws; F.ctl = (unsigned*)(args.ws + WS_CTL);
    const int lo = args.ph_lo, hi = args.ph_hi;
    for (int u = F.tid; u < (LDS_BYTES - MISC_OFF) / 4; u += NWAVES * 64) ((LAS unsigned*)(F.lds + MISC_OFF))[u] = 0u;
    __syncthreads();
    XcdBarrier bar; bar.bar = F.ctl + CW_BAR; bar.x = 0; bar.st = nullptr;
    if (hi - lo > 1) bar = xcd_barrier_post(F.ctl + CW_BAR, (volatile LAS unsigned*)(F.lds + MISC_BAR));
#ifndef PHASE_MASK
#define PHASE_MASK 0x1FFF
#endif
#define IN(k) (((PHASE_MASK >> (k)) & 1) && lo <= (k) && (k) < hi)
#define SEAM(k) do { if (IN(k) && IN((k) + 1)) xcd_barrier(bar); } while (0)
#ifndef REPEAT_MASK
#define REPEAT_MASK 0
#endif
#define REP(k) (((REPEAT_MASK >> (k)) & 1) ? 2 : 1)

    if (IN(0)) { _Pragma("unroll") for (int rep = 0; rep < REP(0); ++rep) { if (rep) xcd_barrier(bar); p0_prologue(F); } } SEAM(0);

    if (IN(1)) { _Pragma("unroll") for (int rep = 0; rep < REP(1); ++rep) { if (rep) xcd_barrier(bar);
        pg8::Gemm g{F.ws + WS_H, F.ws + WS_WIN, DM * (INPROJ_FP8 ? 1 : 2), 0, nullptr, nullptr};
        pg8::StaticOrder S; S.init(NTOK, INWP, F.G, (int)blockIdx.x);
        pg8::EpiBf16 E{(bf16*)(F.ws + WS_PROJ), INWP, nullptr, 0, INPROJ_FP8 ? WSCALE_INV : 1.0f};
        pg8::gemm_phase<pg8::EpiBf16, pg8::StaticOrder, true, true, INPROJ_FP8 != 0>(F.lds + RING_OFF, g, S, E);
    } } SEAM(1);

    if (IN(2)) { _Pragma("unroll") for (int rep = 0; rep < REP(2); ++rep) { if (rep) xcd_barrier(bar); p2_prep1(F); } } SEAM(2);

    if (IN(3)) { _Pragma("unroll") for (int rep = 0; rep < REP(3); ++rep) { if (rep) xcd_barrier(bar);
        { pg8::Gemm g{F.ws + WS_AQ, F.ws + WS_WUQ, QRANK * 2, 0, nullptr, nullptr};
          pg8::StaticOrder S; S.init(NTOK, MH * QKD, F.G, (int)blockIdx.x);
          pg8::EpiBf16 E{(bf16*)(F.ws + WS_QF), MH * QKD, nullptr, 0, 1.0f};
          pg8::gemm_phase<pg8::EpiBf16, pg8::StaticOrder, true, true>(F.lds + RING_OFF, g, S, E); }
        { pg8::Gemm g{F.ws + WS_AKV, F.ws + WS_WUKV, KVRANK * 2, 0, nullptr, nullptr};
          pg8::StaticOrder S; S.init(NTOK, MH * 256, F.G, (int)blockIdx.x);
          pg8::EpiKV E{(bf16*)(F.ws + WS_KVF), (bf16*)(F.ws + WS_KM), F.in[8], (const float*)(F.ws + WS_DQN), (const bf16*)(F.ws + WS_PROJ), (LAS float*)(F.lds + MISC_OFF + 8192)};
          pg8::gemm_phase<pg8::EpiKV, pg8::StaticOrder, true, true>(F.lds + RING_OFF, g, S, E); }
    } }
    if (IN(3) && IN(5)) xcd_barrier(bar);

    if (IN(5)) { _Pragma("unroll") for (int rep = 0; rep < REP(5); ++rep) { if (rep) xcd_barrier(bar); p5_attention(F, rep); } }
    if (IN(5) && IN(7)) xcd_barrier(bar);

    if (IN(7)) { _Pragma("unroll") for (int rep = 0; rep < REP(7); ++rep) { if (rep) xcd_barrier(bar);
        pg8::Gemm g{F.ws + WS_Y, F.ws + WS_WO, DM * 2, 0, nullptr, nullptr};
        pg8::StaticOrder S; S.init(NTOK, DM, F.G, (int)blockIdx.x);
#if X1_BF16
        pg8::EpiResBf16 E{F.in[0], (bf16*)(F.ws + WS_XG), DM};
        pg8::gemm_phase<pg8::EpiResBf16, pg8::StaticOrder, true, true>(F.lds + RING_OFF, g, S, E);
#else
        pg8::EpiResF32 E{F.in[0], F.out, DM, X1_COPY ? (bf16*)(F.ws + WS_XG) : nullptr};
        pg8::gemm_phase<pg8::EpiResF32, pg8::StaticOrder, true, true>(F.lds + RING_OFF, g, S, E);
#endif
    } } SEAM(7);

    if (IN(8)) { _Pragma("unroll") for (int rep = 0; rep < REP(8); ++rep) { if (rep) xcd_barrier(bar); p8_router(F, rep); } } SEAM(8);

    if (IN(9)) { _Pragma("unroll") for (int rep = 0; rep < REP(9); ++rep) { if (rep) xcd_barrier(bar); p9_gather(F); } } SEAM(9);

    if (IN(10)) { _Pragma("unroll") for (int rep = 0; rep < REP(10); ++rep) { if (rep) xcd_barrier(bar);
        const int nblk = moe_tables(F);
        pg8::Gemm g{F.ws + WS_H2, F.ws + WS_WGU, DM, (size_t)2 * DFF * DM, (const int*)(F.ws + WS_STOK), (LAS int*)(F.lds + MISC_ITAB)};
        pg8::MoeOrder S; S.init(nblk, 2 * DFF, F.G, (int)blockIdx.x, (const LAS int*)(F.lds + MISC_BLKE), (const LAS int*)(F.lds + MISC_PADS));
        pg8::EpiGU E{F.ws + WS_ACT, DFF, F.in[21], 2 * DFF, WSCALE_INV};
        pg8::gemm_phase<pg8::EpiGU, pg8::MoeOrder, true, true, true, true>(F.lds + RING_OFF, g, S, E);
    } } SEAM(10);

    if (IN(11)) { _Pragma("unroll") for (int rep = 0; rep < REP(11); ++rep) { if (rep) xcd_barrier(bar);
        const int nblk = moe_tables(F);
        pg8::Gemm g{F.ws + WS_ACT, F.ws + WS_WDN, DFF, (size_t)DM * DFF, nullptr, nullptr};
        pg8::MoeOrder S; S.init(nblk, DM, F.G, (int)blockIdx.x, (const LAS int*)(F.lds + MISC_BLKE), (const LAS int*)(F.lds + MISC_PADS));
#if YS_FP8
        pg8::EpiFp8 E{F.ws + WS_YS, DM, F.in[23], DM, WSCALE_INV};
        pg8::gemm_phase<pg8::EpiFp8, pg8::MoeOrder, true, true, true>(F.lds + RING_OFF, g, S, E);
#else
        pg8::EpiBf16 E{(bf16*)(F.ws + WS_YS), DM, F.in[23], DM, WSCALE_INV};
        pg8::gemm_phase<pg8::EpiBf16, pg8::MoeOrder, true, true, true>(F.lds + RING_OFF, g, S, E);
#endif
    } } SEAM(11);

    if (IN(12)) { _Pragma("unroll") for (int rep = 0; rep < REP(12); ++rep) { if (rep) xcd_barrier(bar); p12_combine(F, rep + 1 < REP(12)); } }
#undef IN
#undef SEAM
}

extern "C" void kernel_launch(void* const* d_in, const int* in_sizes, int n_in, void* d_out, int out_size, void* d_ws, size_t ws_size, hipStream_t stream) {
    static int grid = 0;
    if (grid == 0) {
        if (n_in != 25 || out_size != NTOK * DM || ws_size < WS_END) { fprintf(stderr, "kernel_launch: unexpected shapes: n_in %d out %d ws %zu (need %zu)\n", n_in, out_size, ws_size, (size_t)WS_END); grid = -1; return; }
        int dev = 0, cus = 0, per_cu = 0;
        if (hipGetDevice(&dev) != hipSuccess || hipDeviceGetAttribute(&cus, hipDeviceAttributeMultiprocessorCount, dev) != hipSuccess) { grid = -1; return; }
        if (hipFuncSetAttribute((const void*)mk_fwd, hipFuncAttributeMaxDynamicSharedMemorySize, LDS_BYTES) != hipSuccess) { fprintf(stderr, "kernel_launch: hipFuncSetAttribute failed\n"); grid = -1; return; }
        if (hipOccupancyMaxActiveBlocksPerMultiprocessor(&per_cu, (const void*)mk_fwd, NWAVES * 64, LDS_BYTES) != hipSuccess || per_cu < 1) { fprintf(stderr, "kernel_launch: occupancy query says %d\n", per_cu); }
        (void)hipGetLastError();
        grid = cus;
    }
    if (grid < 0) return;
    if (hipMemsetAsync((char*)d_ws + WS_CTL, 0, CTL_ZERO_BYTES, stream) != hipSuccess) return;
    Args a{};
    for (int i = 0; i < 25; ++i) a.in[i] = (const float*)d_in[i];
    a.out = (float*)d_out; a.ws = (unsigned char*)d_ws;
#if MK_SINGLE
    a.ph_lo = 0; a.ph_hi = N_PHASES;
    hipLaunchKernelGGL(mk_fwd, dim3(grid), dim3(NWAVES * 64), LDS_BYTES, stream, a);
#else
    for (int p = 0; p < N_PHASES; ++p) { a.ph_lo = p; a.ph_hi = p + 1; hipLaunchKernelGGL(mk_fwd, dim3(grid), dim3(NWAVES * 64), LDS_BYTES, stream, a); }
#endif
    const hipError_t le = hipPeekAtLastError();
    if (le != hipSuccess) fprintf(stderr, "kernel_launch: launch failed: %s\n", hipGetErrorName(le));
}
```

```cpp
#include <hip/hip_runtime.h>
#include <cstdio>
#include <cstdint>

#define GAS __attribute__((address_space(1)))
#define LAS __attribute__((address_space(3)))
typedef unsigned short bf16;
typedef unsigned v4u __attribute__((ext_vector_type(4)));
typedef unsigned v2u __attribute__((ext_vector_type(2)));
typedef float f32x4 __attribute__((ext_vector_type(4)));
typedef float f32x2 __attribute__((ext_vector_type(2)));
typedef float f32x16 __attribute__((ext_vector_type(16)));
typedef short bf16x8 __attribute__((ext_vector_type(8)));
typedef short s16x4 __attribute__((ext_vector_type(4)));
#define LDS_WAIT() asm volatile("s_waitcnt lgkmcnt(0)" ::: "memory")
#define VM_WAIT() asm volatile("s_waitcnt vmcnt(0)" ::: "memory")

constexpr int NB = 2, SEQ = 8192, DM = 2048, NTOK = NB * SEQ;
constexpr int INW = 3776, INWP = 3840;
constexpr int C_CQ = 0, C_CKV = 384, C_KR = 640, C_DQ = 704, C_DK = 1728, C_DV = 2752;
constexpr int QRANK = 384, KVRANK = 256, MH = 8, QKD = 192, NOPE = 128, ROPE = 64, VD = 128;
constexpr int DH = 8, DHD = 64;
constexpr int NE = 32, TOPK = 4, DFF = 2048, NASG = NTOK * TOPK, NSLOT_MAX = NASG + NE * 256, NBLK_MAX = NSLOT_MAX / 256;
#ifndef X1_BF16
#define X1_BF16 1
#endif
#ifndef X1_COPY
#define X1_COPY 0
#endif
constexpr float EPS = 1e-6f;
constexpr float LOG2E = 1.4426950408889634f;

constexpr size_t MiB = 1u << 20;
constexpr size_t WS_CTL = 0, CTL_ZERO_BYTES = 1 * MiB;
constexpr size_t WS_WIN = 1 * MiB;
constexpr size_t WS_WUQ = WS_WIN + 15 * MiB;
constexpr size_t WS_WUKV = WS_WUQ + 2 * MiB;
constexpr size_t WS_WO = WS_WUKV + 1 * MiB;
constexpr size_t WS_RW = WS_WO + 8 * MiB;
constexpr size_t WS_WGU = WS_RW + 1 * MiB;
constexpr size_t WS_WDN = WS_WGU + 512 * MiB;
constexpr size_t WS_H = WS_WDN + 256 * MiB;
constexpr size_t WS_PROJ = WS_H + 64 * MiB;
constexpr size_t WS_AQ = WS_PROJ + 120 * MiB;
constexpr size_t WS_AKV = WS_AQ + 12 * MiB;
constexpr size_t WS_DQN = WS_AKV + 8 * MiB;
constexpr size_t WS_DKN = WS_DQN + 32 * MiB;
constexpr size_t WS_QF = WS_DKN + 32 * MiB;
constexpr size_t WS_KVF = WS_QF + 48 * MiB;
constexpr size_t WS_QM = WS_KVF + 64 * MiB;
constexpr size_t WS_KM = WS_QM + 48 * MiB;
constexpr size_t WS_OD = WS_KM + 48 * MiB;
constexpr size_t WS_Y = WS_OD + 128 * MiB;
constexpr size_t WS_H2 = WS_Y + 64 * MiB;
constexpr size_t WS_ASG = WS_H2 + 64 * MiB;
constexpr size_t WS_XG = WS_ASG + 1 * MiB;
constexpr size_t WS_ACT = WS_XG + 288 * MiB;
constexpr size_t WS_YS = WS_ACT + 288 * MiB;
constexpr size_t WS_STOK = WS_YS + 288 * MiB;
constexpr size_t WS_UCNT = WS_STOK + 1 * MiB;
constexpr size_t WS_END = WS_UCNT + 1 * MiB;
constexpr int CW_BAR = 4096;
constexpr int CW_CNT = 16384, CW_CNT_STRIDE = 64;
constexpr int CW_AQ = 8192 + 64;
constexpr int CW_AQ_STRIDE = 64;
constexpr int CW_CONV = 8192 + 64 * 32;

constexpr int RING_OFF = 0, RING_BYTES = 131072;
constexpr int MISC_OFF = RING_BYTES;
constexpr int MISC_BAR = MISC_OFF;
constexpr int MISC_UNIT = MISC_OFF + 64;
constexpr int MISC_PADS = MISC_OFF + 256;
constexpr int MISC_CNTS = MISC_OFF + 512;
constexpr int MISC_BLKE = MISC_OFF + 1024;
constexpr int MISC_ITAB = MISC_OFF + 4096;
constexpr int LDS_BYTES = 147456;

__device__ __forceinline__ unsigned f2bf(float f) { unsigned u = __builtin_bit_cast(unsigned, f); return (u + 0x7fffu + ((u >> 16) & 1u)) >> 16; }
__device__ __forceinline__ unsigned pk2(float lo, float hi) { return f2bf(lo) | (f2bf(hi) << 16); }
__device__ __forceinline__ float bflo(unsigned w) { return __builtin_bit_cast(float, w << 16); }
__device__ __forceinline__ float bfhi(unsigned w) { return __builtin_bit_cast(float, w & 0xffff0000u); }
#ifndef WT_STORES
#define WT_STORES 1
#endif
__device__ __forceinline__ void st16_wt(void* p, v4u v) {
#if WT_STORES
    asm volatile("global_store_dwordx4 %0, %1, off sc0 sc1\n\ts_nop 1" :: "v"(p), "v"(v));
#else
    *(v4u*)p = v;
#endif
}
__device__ __forceinline__ float wave_max(float v) {
#pragma unroll
    for (int o = 1; o < 64; o <<= 1) v = fmaxf(v, __shfl_xor(v, o));
    return v;
}
__device__ __forceinline__ float wave_sum(float v) {
#pragma unroll
    for (int o = 1; o < 64; o <<= 1) v += __shfl_xor(v, o);
    return v;
}

#define XB_TMO      128
#define XB_XCNT(j)  (256  + 64 * (j))
#define XB_XSUB(j)  (1280 + 64 * (j))
#define XB_XGEN(j)  (2304 + 64 * (j))
#define XB_TOP      3328
#define XB_TOPGEN   3392
#define XCD_BAR_WORDS 3456
#define XB_SPIN_CAP (1u << 18)

__device__ __forceinline__ unsigned xb_ld(unsigned* p)              { return __hip_atomic_load(p, __ATOMIC_RELAXED, __HIP_MEMORY_SCOPE_AGENT); }
__device__ __forceinline__ unsigned xb_add(unsigned* p, unsigned v) { return __hip_atomic_fetch_add(p, v, __ATOMIC_RELAXED, __HIP_MEMORY_SCOPE_AGENT); }
__device__ __forceinline__ unsigned xb_xcc_id() { return (unsigned)__builtin_amdgcn_s_getreg((3 << 11) | 20) & 0xFu; }
#define XB_SPIN(cond, bar) do { unsigned _sp = 0; while (cond) { __builtin_amdgcn_s_sleep(1); \
    if ((++_sp & 255u) == 0u) { if (xb_ld(&(bar)[XB_TMO])) break; if (_sp > XB_SPIN_CAP) { atomicAdd(&(bar)[XB_TMO], 1u); break; } } } } while (0)

struct XcdBarrier {
    unsigned* bar; unsigned x;
    volatile LAS unsigned* st;
};

__device__ __forceinline__ XcdBarrier xcd_barrier_post(unsigned* bar, volatile LAS unsigned* st) {
    XcdBarrier b; b.bar = bar; b.x = xb_xcc_id(); b.st = st;
    if (threadIdx.x == 0) (void)xb_add(&bar[XB_XCNT(b.x)], 1u);
    return b;
}
__device__ __forceinline__ void xcd_barrier_complete(unsigned* bar, unsigned x, unsigned& nloc, unsigned& nx) {
    const unsigned G = gridDim.x * gridDim.y * gridDim.z;
    unsigned sum, cnt, mine, sp = 0u;
    for (;;) {
        sum = 0u; cnt = 0u; mine = 0u;
#pragma unroll
        for (unsigned j = 0; j < 16; ++j) { const unsigned c = xb_ld(&bar[XB_XCNT(j)]); sum += c; cnt += (c > 0u) ? 1u : 0u; mine = (j == x) ? c : mine; }
        if (sum == G) break;
        __builtin_amdgcn_s_sleep(1);
        if ((++sp & 255u) == 0u) { if (xb_ld(&bar[XB_TMO])) break; if (sp > XB_SPIN_CAP) { atomicAdd(&bar[XB_TMO], 1u); break; } }
    }
    nloc = mine > 0u ? mine : 1u; nx = cnt > 0u ? cnt : 1u;
}

__device__ __forceinline__ void xcd_barrier(const XcdBarrier& b) {
    asm volatile("s_waitcnt vmcnt(0)" ::: "memory");
    __syncthreads();
    if (threadIdx.x == 0) {
        unsigned* bar = b.bar;
        __builtin_amdgcn_s_waitcnt(0);
        unsigned nloc = b.st[0], nx = b.st[1];
        if (nloc == 0u) { xcd_barrier_complete(bar, b.x, nloc, nx); b.st[0] = nloc; b.st[1] = nx; }
        const unsigned old = xb_add(&bar[XB_XSUB(b.x)], 1u);
        const unsigned gen = old / nloc;
        if (old + 1u == (gen + 1u) * nloc) {
            __builtin_amdgcn_fence(__ATOMIC_RELEASE, "agent");
            asm volatile("s_waitcnt vmcnt(0)" ::: "memory");
            const unsigned og = xb_add(&bar[XB_TOP], 1u);
            const unsigned tg = og / nx;
            if (og + 1u == (tg + 1u) * nx) xb_add(&bar[XB_TOPGEN], 1u);
            else XB_SPIN(xb_ld(&bar[XB_TOPGEN]) == tg, bar);
            __builtin_amdgcn_fence(__ATOMIC_ACQUIRE, "agent");
            xb_add(&bar[XB_XGEN(b.x)], 1u);
            asm volatile("s_waitcnt vmcnt(0)" ::: "memory");
        } else {
            XB_SPIN(xb_ld(&bar[XB_XGEN(b.x)]) == gen, bar);
            __builtin_amdgcn_fence(__ATOMIC_ACQUIRE, "agent");
            asm volatile("s_waitcnt vmcnt(0)" ::: "memory");
        }
    }
    __syncthreads();
}

#ifndef PG8_LATE_ISSUE
#define PG8_LATE_ISSUE 0
#endif
namespace pg8 {
typedef int v4i __attribute__((ext_vector_type(4)));
typedef int v8i __attribute__((ext_vector_type(8)));
constexpr int BM = 256, BK = 64, HALF = 128, HTB = HALF * BK * 2  , STAGE_BYTES = 8 * HTB, NXCD = 8, WGM = 8;

__host__ __device__ __forceinline__ int lds_byte(int r, int c) { const int st = (r >> 4) * 2 + (c >> 5), rr = r & 15, cc = c & 31, ob = rr * 64 + cc * 2; return st * 1024 + (ob ^ (((ob >> 9) & 1) << 5)); }
__host__ __device__ __forceinline__ void stage_rc(int b, int& R, int& C) { const int st = b / 1024, sb = b % 1024, swz = sb ^ (((sb >> 9) & 1) << 5); R = (st >> 1) * 16 + swz / 64; C = (st & 1) * 32 + (swz % 64) / 2; }
__host__ __device__ __forceinline__ int perm32(int rho) { const int n = rho >> 4, i = rho & 15; return 8 * (i >> 2) + 4 * n + (i & 3); }

struct Unit { int pm, pn, e; };
struct Gemm { const void* A; const void* Bt; int rowbytes; size_t bstride_e; const int* rowidx; LAS int* idxtab; };
struct GemmDoc_ { int unused_; };

struct StaticOrder {
    int nM, nN, nwg, G, c;
    __device__ void init(int M, int N, int G_, int c_) { nM = M / BM; nN = N / BM; nwg = nM * nN; G = G_; c = c_; }
    __device__ bool next(int i, Unit& u) const {
        const long L = (long)i * G + c; if (L >= nwg) return false;
        int wgid = (int)L; { const int q = nwg / NXCD, r = nwg % NXCD, xcd = wgid % NXCD, off = wgid / NXCD; wgid = (xcd < r ? xcd * (q + 1) : r * (q + 1) + (xcd - r) * q) + off; }
        const int nig = WGM * nN, gid = wgid / nig, fm = gid * WGM, gsz = (nM - fm) < WGM ? (nM - fm) : WGM;
        u.pm = fm + ((wgid % nig) % gsz); u.pn = (wgid % nig) / gsz; u.e = 0; return true;
    }
};
struct MoeOrder {
    int nM, nN, nwg, G, c; const LAS int* blk_e; const LAS int* pads;
    __device__ void init(int nblk, int N, int G_, int c_, const LAS int* be, const LAS int* pd) { nM = nblk; nN = N / BM; nwg = nM * nN; G = G_; c = c_; blk_e = be; pads = pd; }
    __device__ bool next(int i, Unit& u) const {
        const long L = (long)i * G + c; if (L >= nwg) return false;
        int wgid = (int)L; { const int q = nwg / NXCD, r = nwg % NXCD, xcd = wgid % NXCD, off = wgid / NXCD; wgid = (xcd < r ? xcd * (q + 1) : r * (q + 1) + (xcd - r) * q) + off; }
        const int e = blk_e[wgid / nN], b0 = pads[e] >> 8, nb = (pads[e + 1] - pads[e]) >> 8, local = wgid - b0 * nN;
        u.pn = local / nb; u.pm = b0 + (local - u.pn * nb); u.e = e; return true;
    }
};

__device__ __forceinline__ unsigned cvt_pk_bf16(float lo, float hi) { unsigned r; asm volatile("v_cvt_pk_bf16_f32 %0, %1, %2" : "=v"(r) : "v"(lo), "v"(hi)); return r; }

struct EpiBf16 {
    static constexpr bool PERM = true;
    bf16* O; int ldc; const float* bias; int bias_stride; float scale;
    __device__ __forceinline__ void operator()(const f32x4 (&acc)[2][2][4][2], const Unit& u, int wr, int wc, int fr, int fq) const {
        const int row0 = u.pm * BM + wr * 64 + fr; const int col0 = u.pn * BM + wc * 32 + 8 * fq;
        const float* bp = bias ? bias + (size_t)u.e * bias_stride + col0 : nullptr;
        f32x4 bv[2][2];
#pragma unroll
        for (int bj = 0; bj < 2; ++bj)
#pragma unroll
            for (int n = 0; n < 2; ++n) bv[bj][n] = bias ? *(const f32x4*)(bp + bj * HALF + 4 * n) : (f32x4){0.f, 0.f, 0.f, 0.f};
#pragma unroll
        for (int ai = 0; ai < 2; ++ai)
#pragma unroll
            for (int m = 0; m < 4; ++m) { bf16* rowp = O + (size_t)(row0 + ai * HALF + m * 16) * ldc + col0;
#pragma unroll
                for (int bj = 0; bj < 2; ++bj) { f32x4 v0 = acc[ai][bj][m][0] * scale + bv[bj][0], v1 = acc[ai][bj][m][1] * scale + bv[bj][1];
                    v4u w; w.x = cvt_pk_bf16(v0[0], v0[1]); w.y = cvt_pk_bf16(v0[2], v0[3]); w.z = cvt_pk_bf16(v1[0], v1[1]); w.w = cvt_pk_bf16(v1[2], v1[3]);
                    st16_wt(rowp + bj * HALF, w); } }
    }
};
struct EpiKV {
    static constexpr bool PERM = true;
    bf16* KVF; bf16* KM; const float* gk; const float* krss; const bf16* PROJ; LAS float* part;
    __device__ __forceinline__ void operator()(const f32x4 (&acc)[2][2][4][2], const Unit& u, int wr, int wc, int fr, int fq) const {
        asm volatile("" : "+v"(fr), "+v"(fq));
        typedef unsigned bu4 __attribute__((ext_vector_type(4)));
        const __amdgpu_buffer_rsrc_t rsV = __builtin_amdgcn_make_buffer_rsrc((void*)KVF, (short)0, 0x7FFFFFFF, 0x00020000);
        const __amdgpu_buffer_rsrc_t rsK = __builtin_amdgcn_make_buffer_rsrc((void*)KM, (short)0, 0x7FFFFFFF, 0x00020000);
        const __amdgpu_buffer_rsrc_t rsP = __builtin_amdgcn_make_buffer_rsrc((void*)PROJ, (short)0, 0x7FFFFFFF, 0x00020000);
        const __amdgpu_buffer_rsrc_t rsS = __builtin_amdgcn_make_buffer_rsrc((void*)krss, (short)0, 0x7FFFFFFF, 0x00020000);
        const int h = __builtin_amdgcn_readfirstlane(u.pn), pm = __builtin_amdgcn_readfirstlane(u.pm), rloc0 = wr * 64 + fr;
        const int i0 = 8 * wc + 2 * fq;
        const int voV = (rloc0 * 2048 + HALF + wc * 32 + 8 * fq) * 2, voK = (rloc0 * 1536 + wc * 32 + 8 * fq) * 2, voR = (rloc0 * 1536 + 128 + i0) * 2, voP = (rloc0 * 3840 + 640 + i0) * 2, voS = rloc0 * 4;
        const int sV = (pm * BM * 2048 + h * 256) * 2, sK = (pm * BM * 1536 + h * 192) * 2, sP = pm * BM * 3840 * 2, sS = pm * BM * 4;
#pragma unroll
        for (int ai = 0; ai < 2; ++ai)
#pragma unroll
            for (int m = 0; m < 4; ++m) { const f32x4 v0 = acc[ai][1][m][0], v1 = acc[ai][1][m][1];
                bu4 w; w.x = cvt_pk_bf16(v0[0], v0[1]); w.y = cvt_pk_bf16(v0[2], v0[3]); w.z = cvt_pk_bf16(v1[0], v1[1]); w.w = cvt_pk_bf16(v1[2], v1[3]);
                __builtin_amdgcn_raw_buffer_store_b128(w, rsV, voV, sV + (ai * HALF + m * 16) * 2048 * 2, WT_STORES ? 17 : 0); }
#pragma unroll
        for (int ai = 0; ai < 2; ++ai)
#pragma unroll
            for (int m = 0; m < 4; ++m) { const f32x4 a = acc[ai][0][m][0], b = acc[ai][0][m][1];
                float q = (a[0] * a[0] + a[1] * a[1]) + (a[2] * a[2] + a[3] * a[3]) + (b[0] * b[0] + b[1] * b[1]) + (b[2] * b[2] + b[3] * b[3]);
                q += __shfl_xor(q, 16); q += __shfl_xor(q, 32);
                if (fq == 0) part[wc * 256 + ai * HALF + m * 16 + rloc0] = q; }
        asm volatile("s_waitcnt lgkmcnt(0)" ::: "memory"); __builtin_amdgcn_s_barrier(); asm volatile("" ::: "memory");
        float g8[8];
#pragma unroll
        for (int j = 0; j < 8; ++j) g8[j] = gk[wc * 32 + 8 * fq + j];
        const float invf0 = __builtin_amdgcn_exp2f(-(float)i0 * (13.287712379549449f / 32.0f)), invf1 = __builtin_amdgcn_exp2f(-(float)(i0 + 1) * (13.287712379549449f / 32.0f));
        const float gr0 = gk[128 + i0], gr1 = gk[129 + i0], gs0 = gk[160 + i0], gs1 = gk[161 + i0];
#pragma unroll
        for (int ai = 0; ai < 2; ++ai)
#pragma unroll
            for (int m = 0; m < 4; ++m) { const int dl = ai * HALF + m * 16, rl = dl + rloc0;
                const float ks = __builtin_bit_cast(float, __builtin_amdgcn_raw_buffer_load_b32(rsS, voS, sS + dl * 4, 0));
                const unsigned x1 = __builtin_amdgcn_raw_buffer_load_b32(rsP, voP, sP + dl * 3840 * 2, 0), x2 = __builtin_amdgcn_raw_buffer_load_b32(rsP, voP + 64, sP + dl * 3840 * 2, 0);
                const float tot = (part[rl] + part[256 + rl]) + (part[512 + rl] + part[768 + rl]) + ks;
                const float rstd = 1.0f / sqrtf(tot * (1.f / 192.f) + 1e-6f);
                const f32x4 a = acc[ai][0][m][0], b = acc[ai][0][m][1];
                bu4 w; w.x = cvt_pk_bf16(a[0] * rstd * g8[0], a[1] * rstd * g8[1]); w.y = cvt_pk_bf16(a[2] * rstd * g8[2], a[3] * rstd * g8[3]);
                w.z = cvt_pk_bf16(b[0] * rstd * g8[4], b[1] * rstd * g8[5]); w.w = cvt_pk_bf16(b[2] * rstd * g8[6], b[3] * rstd * g8[7]);
                __builtin_amdgcn_raw_buffer_store_b128(w, rsK, voK, sK + dl * 1536 * 2, WT_STORES ? 17 : 0);
                const float pos = (float)((pm * BM + rl) & 8191);
                float r0 = pos * invf0 * 0.15915494309189535f, r1 = pos * invf1 * 0.15915494309189535f; r0 -= rintf(r0); r1 -= rintf(r1);
                const float sn0 = __builtin_amdgcn_sinf(r0), cs0 = __builtin_amdgcn_cosf(r0), sn1 = __builtin_amdgcn_sinf(r1), cs1 = __builtin_amdgcn_cosf(r1);
                const float a0 = __builtin_bit_cast(float, x1 << 16) * rstd * gr0, a1 = __builtin_bit_cast(float, x1 & 0xffff0000u) * rstd * gr1;
                const float b0 = __builtin_bit_cast(float, x2 << 16) * rstd * gs0, b1 = __builtin_bit_cast(float, x2 & 0xffff0000u) * rstd * gs1;
                __builtin_amdgcn_raw_buffer_store_b32(cvt_pk_bf16(a0 * cs0 - b0 * sn0, a1 * cs1 - b1 * sn1), rsK, voR, sK + dl * 1536 * 2, 0);
                __builtin_amdgcn_raw_buffer_store_b32(cvt_pk_bf16(b0 * cs0 + a0 * sn0, b1 * cs1 + a1 * sn1), rsK, voR + 64, sK + dl * 1536 * 2, 0); }
    }
};
__device__ __forceinline__ float swiglu(float g, float u) {
    g = fminf(g, 7.0f); u = fminf(fmaxf(u, -7.0f), 7.0f);
    const float s = __builtin_amdgcn_rcpf(1.0f + __builtin_amdgcn_exp2f(g * (-1.702f * 1.4426950408889634f)));
    return g * s * (u + 1.0f);
}
__device__ __forceinline__ unsigned pk4_fp8(float a, float b, float c, float d) {
    a = __builtin_amdgcn_fmed3f(a, 448.0f, -448.0f); b = __builtin_amdgcn_fmed3f(b, 448.0f, -448.0f); c = __builtin_amdgcn_fmed3f(c, 448.0f, -448.0f); d = __builtin_amdgcn_fmed3f(d, 448.0f, -448.0f);
    int w = __builtin_amdgcn_cvt_pk_fp8_f32(a, b, 0, false); w = __builtin_amdgcn_cvt_pk_fp8_f32(c, d, w, true); return (unsigned)w;
}
struct EpiGU {
    static constexpr bool PERM = true;
    unsigned char* O; int ldc; const float* bias; int bias_stride; float scale;
    __device__ __forceinline__ void operator()(const f32x4 (&acc)[2][2][4][2], const Unit& u, int wr, int wc, int fr, int fq) const {
        const int row0 = u.pm * BM + wr * 64 + fr; const int col0 = u.pn * BM + wc * 32 + 8 * fq;
        const float* bp = bias + (size_t)u.e * bias_stride + col0;
        f32x4 bv[2][2];
#pragma unroll
        for (int bj = 0; bj < 2; ++bj)
#pragma unroll
            for (int n = 0; n < 2; ++n) bv[bj][n] = *(const f32x4*)(bp + bj * HALF + 4 * n);
#pragma unroll
        for (int ai = 0; ai < 2; ++ai)
#pragma unroll
            for (int m = 0; m < 4; ++m) { unsigned char* rowp = O + (size_t)(row0 + ai * HALF + m * 16) * ldc + (col0 >> 1);
#pragma unroll
                for (int bj = 0; bj < 2; ++bj) { const f32x4 v0 = acc[ai][bj][m][0] * scale + bv[bj][0], v1 = acc[ai][bj][m][1] * scale + bv[bj][1];
                    *(unsigned*)(rowp + bj * (HALF / 2)) = pk4_fp8(swiglu(v0[0], v0[1]), swiglu(v0[2], v0[3]), swiglu(v1[0], v1[1]), swiglu(v1[2], v1[3])); } }
    }
};
struct EpiFp8 {
    static constexpr bool PERM = true;
    unsigned char* O; int ldc; const float* bias; int bias_stride; float scale;
    __device__ __forceinline__ void operator()(const f32x4 (&acc)[2][2][4][2], const Unit& u, int wr, int wc, int fr, int fq) const {
        const int row0 = u.pm * BM + wr * 64 + fr; const int col0 = u.pn * BM + wc * 32 + 8 * fq;
        const float* bp = bias + (size_t)u.e * bias_stride + col0;
        f32x4 bv[2][2];
#pragma unroll
        for (int bj = 0; bj < 2; ++bj)
#pragma unroll
            for (int n = 0; n < 2; ++n) bv[bj][n] = *(const f32x4*)(bp + bj * HALF + 4 * n);
#pragma unroll
        for (int ai = 0; ai < 2; ++ai)
#pragma unroll
            for (int m = 0; m < 4; ++m) { unsigned char* rowp = O + (size_t)(row0 + ai * HALF + m * 16) * ldc + col0;
#pragma unroll
                for (int bj = 0; bj < 2; ++bj) { const f32x4 v0 = acc[ai][bj][m][0] * scale + bv[bj][0], v1 = acc[ai][bj][m][1] * scale + bv[bj][1];
                    v2u w; w.x = pk4_fp8(v0[0], v0[1], v0[2], v0[3]); w.y = pk4_fp8(v1[0], v1[1], v1[2], v1[3]);
                    *(v2u*)(rowp + bj * HALF) = w; } }
    }
};
struct EpiResF32 {
    static constexpr bool PERM = false;
    const float* base; float* out; int ldc; bf16* out16;
    __device__ __forceinline__ void operator()(const f32x4 (&acc)[2][2][4][2], const Unit& u, int wr, int wc, int fr, int fq) const {
        const int row0 = u.pm * BM + wr * 64 + fr; const int col0 = u.pn * BM + wc * 32 + 4 * fq;
#pragma unroll
        for (int ai = 0; ai < 2; ++ai)
#pragma unroll
            for (int m = 0; m < 4; ++m) { const size_t off = (size_t)(row0 + ai * HALF + m * 16) * ldc + col0;
#pragma unroll
                for (int bj = 0; bj < 2; ++bj)
#pragma unroll
                    for (int n = 0; n < 2; ++n) { const f32x4 b = *(const f32x4*)(base + off + bj * HALF + n * 16); const f32x4 r = b + acc[ai][bj][m][n];
                        *(f32x4*)(out + off + bj * HALF + n * 16) = r;
                        if (out16) { v2u w; w.x = cvt_pk_bf16(r[0], r[1]); w.y = cvt_pk_bf16(r[2], r[3]); *(v2u*)(out16 + off + bj * HALF + n * 16) = w; } } }
    }
};

struct EpiResBf16 {
    static constexpr bool PERM = true;
    const float* base; bf16* out16; int ldc;
    __device__ __forceinline__ void operator()(const f32x4 (&acc)[2][2][4][2], const Unit& u, int wr, int wc, int fr, int fq) const {
        const int row0 = u.pm * BM + wr * 64 + fr; const int col0 = u.pn * BM + wc * 32 + 8 * fq;
#pragma unroll
        for (int ai = 0; ai < 2; ++ai)
#pragma unroll
            for (int m = 0; m < 4; ++m) { const size_t off = (size_t)(row0 + ai * HALF + m * 16) * ldc + col0;
#pragma unroll
                for (int bj = 0; bj < 2; ++bj) { const f32x4 b0 = *(const f32x4*)(base + off + bj * HALF), b1 = *(const f32x4*)(base + off + bj * HALF + 4);
                    const f32x4 r0 = b0 + acc[ai][bj][m][0], r1 = b1 + acc[ai][bj][m][1];
                    v4u w; w.x = cvt_pk_bf16(r0[0], r0[1]); w.y = cvt_pk_bf16(r0[2], r0[3]); w.z = cvt_pk_bf16(r1[0], r1[1]); w.w = cvt_pk_bf16(r1[2], r1[3]);
                    st16_wt(out16 + off + bj * HALF, w); } }
    }
};

template <class Epi, class Sched, bool ALIGN_EPI = false, bool SP2 = false, bool FP8 = false, bool GATHER = false>
__device__ __forceinline__ void gemm_phase(LAS unsigned char* lds, const Gemm g, const Sched& S, const Epi& E) {
    const int tid = threadIdx.x, wid = __builtin_amdgcn_readfirstlane(tid >> 6), lane = tid & 63, wr = wid >> 2, wc = wid & 3, fr = lane & 15, fq = lane >> 4;
    const int RB = g.rowbytes, nt = RB / 128;
    unsigned voffA[2], voffB[2]; int rowA[2], colA[2];
#pragma unroll
    for (int i = 0; i < 2; ++i) { int R, C; stage_rc(tid * 16 + i * 8192, R, C); const int Rb = Epi::PERM ? ((R & ~31) + perm32(R & 31)) : R;
        voffA[i] = (unsigned)(R * RB + C * 2); voffB[i] = (unsigned)(Rb * RB + C * 2); rowA[i] = R; colA[i] = C * 2; }
    unsigned cvA[2][2], nvA[2][2];
    const unsigned kstep = 128u;
    const unsigned hstep = (unsigned)HALF * (unsigned)RB;
    const unsigned tstep = 2u * hstep;
    const __amdgpu_buffer_rsrc_t rsA = __builtin_amdgcn_make_buffer_rsrc((void*)g.A, (short)0, 0x7FFFFFFF, 0x00020000);
    const __amdgpu_buffer_rsrc_t rsB = __builtin_amdgcn_make_buffer_rsrc((void*)g.Bt, (short)0, 0x7FFFFFFF, 0x00020000);
    const unsigned ldsw = (unsigned)wid * 1024u;
    const int aoff = lds_byte(wr * 64 + fr, fq * 8), boff = lds_byte(wc * 32 + fr, fq * 8);
#define PG8_SA(b, h) (((b) * 2 + (h)) * HTB)
#define PG8_SB(b, h) ((4 + (b) * 2 + (h)) * HTB)
#define PG8_STAGE(bufoff, soff, voff) do { _Pragma("unroll") for (int _i = 0; _i < 2; ++_i) \
        __builtin_amdgcn_raw_ptr_buffer_load_lds(rs_##voff, (LAS void*)(lds + (bufoff) + ldsw + _i * 8192), 16, (int)(voff)[_i], (int)(soff), 0, 0); } while (0)
#define rs_voffA rsA
#define rs_voffB rsB
#define PG8_STAGE_A(bufoff, soff, h, NXT) do { _Pragma("unroll") for (int _i = 0; _i < 2; ++_i) { unsigned vo_, so_; \
        if constexpr (GATHER) { vo_ = (NXT) ? nvA[h][_i] : cvA[h][_i]; so_ = (soff); } else { vo_ = voffA[_i]; so_ = (soff) + (h) * hstep; } \
        __builtin_amdgcn_raw_ptr_buffer_load_lds(rsA, (LAS void*)(lds + (bufoff) + ldsw + _i * 8192), 16, (int)vo_, (int)so_, 0, 0); } } while (0)
#define PG8_LD16(off) (*(const LAS v4i*)(lds + (off)))
#define PG8_LDA(dst, b, h) do { _Pragma("unroll") for (int m = 0; m < 4; ++m) { if constexpr (FP8) { const v4i lo_ = PG8_LD16(PG8_SA(b, h) + aoff + m * 2048), hi_ = PG8_LD16(PG8_SA(b, h) + aoff + m * 2048 + 1024); dst##8[m] = __builtin_shufflevector(lo_, hi_, 0, 1, 2, 3, 4, 5, 6, 7); } \
        else { _Pragma("unroll") for (int k = 0; k < 2; ++k) dst[m][k] = *(const LAS bf16x8*)(lds + PG8_SA(b, h) + aoff + m * 2048 + k * 1024); } } } while (0)
#define PG8_LDB(dst, b, h) do { _Pragma("unroll") for (int n = 0; n < 2; ++n) { if constexpr (FP8) { const v4i lo_ = PG8_LD16(PG8_SB(b, h) + boff + n * 2048), hi_ = PG8_LD16(PG8_SB(b, h) + boff + n * 2048 + 1024); dst##8[n] = __builtin_shufflevector(lo_, hi_, 0, 1, 2, 3, 4, 5, 6, 7); } \
        else { _Pragma("unroll") for (int k = 0; k < 2; ++k) dst[n][k] = *(const LAS bf16x8*)(lds + PG8_SB(b, h) + boff + n * 2048 + k * 1024); } } } while (0)
#define PG8_MMA(ai, bj, At, Bt) do { __builtin_amdgcn_s_setprio(1); _Pragma("unroll") for (int m = 0; m < 4; ++m) _Pragma("unroll") for (int n = 0; n < 2; ++n) { \
        if constexpr (FP8) { asm volatile("v_mfma_scale_f32_16x16x128_f8f6f4 %0, %1, %2, %0, %3, %3 op_sel_hi:[0,0,0]" : "+v"(acc[ai][bj][m][n]) : "v"(Bt##8[n]), "v"(At##8[m]), "v"(sc1)); } \
        else { _Pragma("unroll") for (int k = 0; k < 2; ++k) acc[ai][bj][m][n] = __builtin_amdgcn_mfma_f32_16x16x32_bf16(Bt[n][k], At[m][k], acc[ai][bj][m][n], 0, 0, 0); } } \
        __builtin_amdgcn_s_setprio(0); } while (0)
#define PG8_WAIT_V(n) asm volatile("s_waitcnt vmcnt(" #n ")" ::: "memory")
#define PG8_WAIT_L(n) asm volatile("s_waitcnt lgkmcnt(" #n ")" ::: "memory")
#define PG8_BAR __builtin_amdgcn_s_barrier()
#define PG8_SCHED __builtin_amdgcn_sched_barrier(0)
    Unit cur, nxt; int ui = 0;
    if (!S.next(0, cur)) return;
    f32x4 acc[2][2][4][2];
#pragma unroll
    for (int a = 0; a < 2; ++a)
#pragma unroll
        for (int b = 0; b < 2; ++b)
#pragma unroll
            for (int m = 0; m < 4; ++m)
#pragma unroll
                for (int n = 0; n < 2; ++n) acc[a][b][m][n] = (f32x4){0.f, 0.f, 0.f, 0.f};
    int sc1 = 0x7F7F7F7F; asm volatile("" : "+v"(sc1));
    bf16x8 At[4][2], B0[2][2], B1[2][2]; v8i At8[4], B08[2], B18[2];
    unsigned cA = GATHER ? 0u : (unsigned)__builtin_amdgcn_readfirstlane(cur.pm) * tstep, cB = (unsigned)__builtin_amdgcn_readfirstlane(cur.e) * (unsigned)g.bstride_e + (unsigned)__builtin_amdgcn_readfirstlane(cur.pn) * tstep;
    const __amdgpu_buffer_rsrc_t rsI = __builtin_amdgcn_make_buffer_rsrc((void*)g.rowidx, (short)0, 0x7FFFFFFF, 0x00020000);
    if constexpr (GATHER) {
#pragma unroll
        for (int h = 0; h < 2; ++h)
#pragma unroll
            for (int i = 0; i < 2; ++i) cvA[h][i] = (unsigned)g.rowidx[cur.pm * BM + h * HALF + rowA[i]] * (unsigned)RB + (unsigned)colA[i];
    }
    if constexpr (SP2) {
        PG8_STAGE(PG8_SB(0, 0), cB, voffB); PG8_STAGE(PG8_SB(0, 1), cB + hstep, voffB); PG8_STAGE_A(PG8_SA(0, 0), cA, 0, false); PG8_STAGE_A(PG8_SA(0, 1), cA, 1, false);
        if (wr == 1) PG8_BAR;
        PG8_WAIT_V(2); PG8_BAR;
        PG8_STAGE(PG8_SB(1, 0), cB + kstep, voffB); PG8_STAGE_A(PG8_SA(1, 0), cA + kstep, 0, false); PG8_STAGE(PG8_SB(1, 1), cB + hstep + kstep, voffB);
        PG8_WAIT_V(6); PG8_BAR;
    } else {
        PG8_STAGE(PG8_SB(0, 0), cB, voffB); PG8_STAGE_A(PG8_SA(0, 0), cA, 0, false); PG8_STAGE(PG8_SB(0, 1), cB + hstep, voffB); PG8_STAGE_A(PG8_SA(0, 1), cA, 1, false);
        if (wr == 1) PG8_BAR;
        PG8_WAIT_V(4); PG8_BAR;
        PG8_STAGE(PG8_SB(1, 0), cB + kstep, voffB); PG8_STAGE_A(PG8_SA(1, 0), cA + kstep, 0, false); PG8_STAGE(PG8_SB(1, 1), cB + hstep + kstep, voffB);
        PG8_WAIT_V(6); PG8_BAR;
    }
    for (;;) {
        const bool has_next = S.next(ui + 1, nxt);
        const unsigned nA = (has_next && !GATHER) ? (unsigned)__builtin_amdgcn_readfirstlane(nxt.pm) * tstep : cA;
        LAS int* itab = g.idxtab + (ui & 1) * BM;
        if constexpr (GATHER) { if (has_next && wid < 4) __builtin_amdgcn_raw_ptr_buffer_load_lds(rsI, (LAS void*)(itab + wid * 64), 4, (int)(lane * 4), (int)(((unsigned)__builtin_amdgcn_readfirstlane(nxt.pm) * BM + wid * 64) * 4u), 0, 0); }
        const unsigned nB = has_next ? (unsigned)__builtin_amdgcn_readfirstlane(nxt.e) * (unsigned)g.bstride_e + (unsigned)__builtin_amdgcn_readfirstlane(nxt.pn) * tstep : cB;
        for (int t = 0; t < nt; t += 2) {
            const bool last = (t == nt - 2);
            const unsigned a1 = cA + (unsigned)(t + 1) * kstep;
            const unsigned a2 = last ? nA : cA + (unsigned)(t + 2) * kstep, b2 = last ? nB : cB + (unsigned)(t + 2) * kstep;
            const unsigned a3 = a2 + kstep, b3 = b2 + kstep;
            if constexpr (GATHER) { if (last && has_next) {
                _Pragma("unroll") for (int h = 0; h < 2; ++h) _Pragma("unroll") for (int i = 0; i < 2; ++i) nvA[h][i] = (unsigned)itab[h * HALF + rowA[i]] * (unsigned)RB + (unsigned)colA[i]; }
              else if (last) { _Pragma("unroll") for (int h = 0; h < 2; ++h) _Pragma("unroll") for (int i = 0; i < 2; ++i) nvA[h][i] = cvA[h][i]; } }
            if constexpr (SP2) {
#if PG8_LATE_ISSUE == 2
            PG8_LDB(B0, 0, 0); PG8_LDB(B1, 0, 1); PG8_SCHED; PG8_LDA(At, 0, 0); PG8_STAGE_A(PG8_SA(1, 1), a1, 1, false);
            PG8_WAIT_V(8); PG8_WAIT_L(0); PG8_BAR; PG8_MMA(0, 0, At, B0); PG8_MMA(0, 1, At, B1); PG8_BAR; PG8_SCHED;
            PG8_LDA(At, 0, 1); PG8_STAGE(PG8_SB(0, 0), b2, voffB); PG8_STAGE(PG8_SB(0, 1), b2 + hstep, voffB);
            PG8_WAIT_V(6); PG8_WAIT_L(0); PG8_BAR; PG8_MMA(1, 0, At, B0); PG8_STAGE_A(PG8_SA(0, 0), a2, 0, last); PG8_MMA(1, 1, At, B1); PG8_BAR; PG8_SCHED;
            PG8_LDB(B0, 1, 0); PG8_LDB(B1, 1, 1); PG8_SCHED; PG8_LDA(At, 1, 0); PG8_STAGE_A(PG8_SA(0, 1), a2, 1, last);
            PG8_WAIT_V(8); PG8_WAIT_L(0); PG8_BAR; PG8_MMA(0, 0, At, B0); PG8_MMA(0, 1, At, B1); PG8_BAR; PG8_SCHED;
            PG8_LDA(At, 1, 1); PG8_STAGE(PG8_SB(1, 0), b3, voffB); PG8_STAGE(PG8_SB(1, 1), b3 + hstep, voffB);
            PG8_WAIT_V(6); PG8_WAIT_L(0); PG8_BAR; PG8_MMA(1, 0, At, B0); PG8_STAGE_A(PG8_SA(1, 0), a3, 0, last); PG8_MMA(1, 1, At, B1); PG8_BAR; PG8_SCHED;
#else
            PG8_LDB(B0, 0, 0); PG8_LDB(B1, 0, 1); PG8_SCHED; PG8_LDA(At, 0, 0); PG8_STAGE_A(PG8_SA(1, 1), a1, 1, false);
            PG8_WAIT_V(8); PG8_WAIT_L(0); PG8_BAR; PG8_MMA(0, 0, At, B0); PG8_MMA(0, 1, At, B1); PG8_BAR; PG8_SCHED;
            PG8_LDA(At, 0, 1); PG8_STAGE(PG8_SB(0, 0), b2, voffB); PG8_STAGE(PG8_SB(0, 1), b2 + hstep, voffB); PG8_STAGE_A(PG8_SA(0, 0), a2, 0, last);
            PG8_WAIT_V(8); PG8_WAIT_L(0); PG8_BAR; PG8_MMA(1, 0, At, B0); PG8_MMA(1, 1, At, B1); PG8_BAR; PG8_SCHED;
            PG8_LDB(B0, 1, 0); PG8_LDB(B1, 1, 1); PG8_SCHED; PG8_LDA(At, 1, 0); PG8_STAGE_A(PG8_SA(0, 1), a2, 1, last);
            PG8_WAIT_V(8); PG8_WAIT_L(0); PG8_BAR; PG8_MMA(0, 0, At, B0); PG8_MMA(0, 1, At, B1); PG8_BAR; PG8_SCHED;
            PG8_LDA(At, 1, 1); PG8_STAGE(PG8_SB(1, 0), b3, voffB); PG8_STAGE(PG8_SB(1, 1), b3 + hstep, voffB); PG8_STAGE_A(PG8_SA(1, 0), a3, 0, last);
            PG8_WAIT_V(8); PG8_WAIT_L(0); PG8_BAR; PG8_MMA(1, 0, At, B0); PG8_MMA(1, 1, At, B1); PG8_BAR; PG8_SCHED;
#endif
            } else {
            PG8_LDB(B0, 0, 0); PG8_SCHED; PG8_LDA(At, 0, 0); PG8_STAGE_A(PG8_SA(1, 1), a1, 1, false);
            PG8_WAIT_L(8); PG8_BAR; PG8_WAIT_L(0); PG8_MMA(0, 0, At, B0); PG8_BAR; PG8_SCHED;
            PG8_LDB(B1, 0, 1); PG8_STAGE(PG8_SB(0, 0), b2, voffB);
            PG8_BAR; PG8_WAIT_L(0); PG8_MMA(0, 1, At, B1); PG8_BAR;
            PG8_LDA(At, 0, 1); PG8_STAGE_A(PG8_SA(0, 0), a2, 0, last);
            PG8_BAR; PG8_WAIT_L(0); PG8_MMA(1, 0, At, B0); PG8_BAR; PG8_SCHED;
            PG8_STAGE(PG8_SB(0, 1), b2 + hstep, voffB);
            PG8_WAIT_V(6); PG8_BAR; PG8_MMA(1, 1, At, B1); PG8_BAR;
            PG8_LDB(B0, 1, 0); PG8_SCHED; PG8_LDA(At, 1, 0); PG8_STAGE_A(PG8_SA(0, 1), a2, 1, last);
            PG8_WAIT_L(8); PG8_BAR; PG8_WAIT_L(0); PG8_MMA(0, 0, At, B0); PG8_BAR; PG8_SCHED;
            PG8_LDB(B1, 1, 1); PG8_STAGE(PG8_SB(1, 0), b3, voffB);
            PG8_BAR; PG8_WAIT_L(0); PG8_MMA(0, 1, At, B1); PG8_BAR;
            PG8_LDA(At, 1, 1); PG8_STAGE_A(PG8_SA(1, 0), a3, 0, last);
            PG8_BAR; PG8_WAIT_L(0); PG8_MMA(1, 0, At, B0); PG8_BAR; PG8_SCHED;
            PG8_STAGE(PG8_SB(1, 1), b3 + hstep, voffB);
            PG8_WAIT_V(6); PG8_BAR; PG8_MMA(1, 1, At, B1); PG8_BAR;
            }
        }
        if constexpr (ALIGN_EPI) { if (wr == 0) PG8_BAR; }
        if constexpr (FP8) asm volatile("s_nop 15\n\ts_nop 15" ::: "memory");
        E(acc, cur, wr, wc, fr, fq);
        if (!has_next) break;
#pragma unroll
        for (int a = 0; a < 2; ++a)
#pragma unroll
            for (int b = 0; b < 2; ++b)
#pragma unroll
                for (int m = 0; m < 4; ++m)
#pragma unroll
                    for (int n = 0; n < 2; ++n) acc[a][b][m][n] = (f32x4){0.f, 0.f, 0.f, 0.f};
        cur = nxt; cA = nA; cB = nB; ++ui;
        if constexpr (GATHER) { _Pragma("unroll") for (int h = 0; h < 2; ++h) _Pragma("unroll") for (int i = 0; i < 2; ++i) cvA[h][i] = nvA[h][i]; }
        if constexpr (ALIGN_EPI) { if (wr == 1) PG8_BAR; }
    }
    PG8_WAIT_V(0);
    if constexpr (!ALIGN_EPI) { if (wr == 0) PG8_BAR; }
    PG8_BAR;
#undef PG8_SA
#undef PG8_SB
#undef PG8_STAGE
#undef PG8_STAGE_A
#undef rs_voffA
#undef rs_voffB
#undef PG8_LD16
#undef PG8_LDA
#undef PG8_LDB
#undef PG8_MMA
#undef PG8_WAIT_V
#undef PG8_WAIT_L
#undef PG8_BAR
#undef PG8_SCHED
}
}

namespace att {
constexpr int KVBLK = 64;
constexpr int SHM_V = KVBLK * 128 * 2;
constexpr int OFF_V = 0, OFF_K = 3 * SHM_V;
constexpr int OFF_WS = OFF_K + 3 * 24576;
constexpr int OFF_TAB = OFF_WS + 8 * 256;
constexpr int OFF_GQ = OFF_TAB + 1024;
constexpr int ATT_LDS_END = OFF_GQ + 1024;
static_assert(ATT_LDS_END <= RING_BYTES, "attention LDS");
constexpr float THR2 = 8.0f * 1.4426950408889634f;

__device__ __forceinline__ int crow(int r, int hi) { return (r & 3) + 8 * (r >> 2) + 4 * hi; }
__device__ __forceinline__ unsigned cvtpk(float lo, float hi) { unsigned r; asm volatile("v_cvt_pk_bf16_f32 %0, %1, %2" : "=v"(r) : "v"(lo), "v"(hi)); return r; }
__device__ __forceinline__ int v_rd_base(int lane) { return ((lane & 3) << 3) | (((lane >> 2) & 3) << 6) | (((lane >> 4) & 1) << 5) | (((lane >> 5) & 1) << 8); }
constexpr int v_rd_off(int d0, int ks, int half) { return d0 * 512 + ks * 4096 + half * 2048; }
template <int OFF> __device__ __forceinline__ s16x4 tr_read(int vb) {
    s16x4 r; asm volatile("ds_read_b64_tr_b16 %0, %1 offset:%2" : "=&v"(r) : "v"(vb), "i"(OFF) : "memory"); return r;
}
template <int D0> __device__ __forceinline__ void pv_one(f32x16& od, int vb, bf16x8 pa0, bf16x8 pa1, bf16x8 pa2, bf16x8 pa3) {
    const s16x4 l0 = tr_read<v_rd_off(D0, 0, 0)>(vb), h0 = tr_read<v_rd_off(D0, 0, 1)>(vb), l1 = tr_read<v_rd_off(D0, 1, 0)>(vb), h1 = tr_read<v_rd_off(D0, 1, 1)>(vb);
    const s16x4 l2 = tr_read<v_rd_off(D0, 2, 0)>(vb), h2 = tr_read<v_rd_off(D0, 2, 1)>(vb), l3 = tr_read<v_rd_off(D0, 3, 0)>(vb), h3 = tr_read<v_rd_off(D0, 3, 1)>(vb);
    asm volatile("s_waitcnt lgkmcnt(0)" ::: "memory"); __builtin_amdgcn_sched_barrier(0);
#define PK(L, H) (bf16x8){L[0], L[1], L[2], L[3], H[0], H[1], H[2], H[3]}
    od = __builtin_amdgcn_mfma_f32_32x32x16_bf16(pa0, PK(l0, h0), od, 0, 0, 0);
    od = __builtin_amdgcn_mfma_f32_32x32x16_bf16(pa1, PK(l1, h1), od, 0, 0, 0);
    od = __builtin_amdgcn_mfma_f32_32x32x16_bf16(pa2, PK(l2, h2), od, 0, 0, 0);
    od = __builtin_amdgcn_mfma_f32_32x32x16_bf16(pa3, PK(l3, h3), od, 0, 0, 0);
#undef PK
}
__device__ __forceinline__ void pv_pre(s16x4 (&vf)[8], int vb) {
    vf[0] = tr_read<v_rd_off(0, 0, 0)>(vb); vf[1] = tr_read<v_rd_off(0, 0, 1)>(vb); vf[2] = tr_read<v_rd_off(0, 1, 0)>(vb); vf[3] = tr_read<v_rd_off(0, 1, 1)>(vb);
    vf[4] = tr_read<v_rd_off(0, 2, 0)>(vb); vf[5] = tr_read<v_rd_off(0, 2, 1)>(vb); vf[6] = tr_read<v_rd_off(0, 3, 0)>(vb); vf[7] = tr_read<v_rd_off(0, 3, 1)>(vb);
}
template <int D0> __device__ __forceinline__ void pv_rd(s16x4 (&g)[8], int vb) {
    g[0] = tr_read<v_rd_off(D0, 0, 0)>(vb); g[1] = tr_read<v_rd_off(D0, 0, 1)>(vb); g[2] = tr_read<v_rd_off(D0, 1, 0)>(vb); g[3] = tr_read<v_rd_off(D0, 1, 1)>(vb);
    g[4] = tr_read<v_rd_off(D0, 2, 0)>(vb); g[5] = tr_read<v_rd_off(D0, 2, 1)>(vb); g[6] = tr_read<v_rd_off(D0, 3, 0)>(vb); g[7] = tr_read<v_rd_off(D0, 3, 1)>(vb);
}
__device__ __forceinline__ void pv_mm(f32x16& od, bf16x8 pa0, bf16x8 pa1, bf16x8 pa2, bf16x8 pa3, const s16x4 (&g)[8]) {
#define PK(L, H) (bf16x8){L[0], L[1], L[2], L[3], H[0], H[1], H[2], H[3]}
    od = __builtin_amdgcn_mfma_f32_32x32x16_bf16(pa0, PK(g[0], g[1]), od, 0, 0, 0);
    od = __builtin_amdgcn_mfma_f32_32x32x16_bf16(pa1, PK(g[2], g[3]), od, 0, 0, 0);
    od = __builtin_amdgcn_mfma_f32_32x32x16_bf16(pa2, PK(g[4], g[5]), od, 0, 0, 0);
    od = __builtin_amdgcn_mfma_f32_32x32x16_bf16(pa3, PK(g[6], g[7]), od, 0, 0, 0);
#undef PK
}
__device__ __forceinline__ void pv_all_pre(f32x16 (&o)[4], int vb, bf16x8 pa0, bf16x8 pa1, bf16x8 pa2, bf16x8 pa3, const s16x4 (&vf)[8]) {
    s16x4 g1[8], g2[8], g3[8];
#define LW(n) do { __builtin_amdgcn_sched_barrier(0); asm volatile("s_waitcnt lgkmcnt(" #n ")" ::: "memory"); __builtin_amdgcn_sched_barrier(0); } while (0)
    LW(4); pv_rd<1>(g1, vb);
    LW(8); pv_mm(o[0], pa0, pa1, pa2, pa3, vf);
    LW(4); pv_rd<2>(g2, vb);
    LW(8); pv_mm(o[1], pa0, pa1, pa2, pa3, g1);
    LW(4); pv_rd<3>(g3, vb);
    LW(8); pv_mm(o[2], pa0, pa1, pa2, pa3, g2);
    LW(0); pv_mm(o[3], pa0, pa1, pa2, pa3, g3);
#undef LW
}
__device__ __forceinline__ void pv_all(f32x16 (&o)[4], int vb, bf16x8 pa0, bf16x8 pa1, bf16x8 pa2, bf16x8 pa3) {
    pv_one<0>(o[0], vb, pa0, pa1, pa2, pa3); pv_one<1>(o[1], vb, pa0, pa1, pa2, pa3); pv_one<2>(o[2], vb, pa0, pa1, pa2, pa3); pv_one<3>(o[3], vb, pa0, pa1, pa2, pa3);
}
#ifndef QK_AHEAD64
#define QK_AHEAD64 1
#endif
#ifndef QK_AHEAD
#define QK_AHEAD 4
#endif
template <int DQK, bool BIAS, bool VPRE = false> __device__ __forceinline__ void qkt(f32x16& p0, f32x16& p1, const LAS unsigned char* Ks, const bf16x8 (&qr)[DQK / 16], int r32, int hi, int vb = 0, s16x4 (*vf)[8] = nullptr) {
    constexpr int KROW = DQK * 2, N = DQK / 16;
#pragma unroll
    for (int r = 0; r < 16; ++r) { p0[r] = 0.f; p1[r] = 0.f; }
#define QK_LO(d0) ((((((d0) & 3) * 32 + hi * 16) ^ (((r32 >> 1) & 7) << 4)) + r32 * KROW) + ((d0) >> 2) * 128)
    if constexpr (DQK == 192 && QK_AHEAD > 0) {
        bf16x8 f0[N], f1[N];
#pragma unroll
        for (int d0 = 0; d0 < QK_AHEAD; ++d0) { f0[d0] = *(const LAS bf16x8*)(Ks + QK_LO(d0)); f1[d0] = *(const LAS bf16x8*)(Ks + QK_LO(d0) + 32 * KROW); }
#pragma unroll
        for (int d0 = 0; d0 < N; ++d0) {
            if (d0 + QK_AHEAD < N) { f0[d0 + QK_AHEAD] = *(const LAS bf16x8*)(Ks + QK_LO(d0 + QK_AHEAD)); f1[d0 + QK_AHEAD] = *(const LAS bf16x8*)(Ks + QK_LO(d0 + QK_AHEAD) + 32 * KROW); }
            if constexpr (VPRE) { if (d0 == N - 3) pv_pre(*vf, vb); }
            __builtin_amdgcn_sched_barrier(0);
            p0 = __builtin_amdgcn_mfma_f32_32x32x16_bf16(f0[d0], qr[d0], p0, 0, 0, 0);
            p1 = __builtin_amdgcn_mfma_f32_32x32x16_bf16(f1[d0], qr[d0], p1, 0, 0, 0);
            __builtin_amdgcn_sched_barrier(0);
        }
    } else if constexpr (DQK == 64 && QK_AHEAD64) {
        bf16x8 f0[N], f1[N];
#pragma unroll
        for (int d0 = 0; d0 < N; ++d0) { f0[d0] = *(const LAS bf16x8*)(Ks + QK_LO(d0)); f1[d0] = *(const LAS bf16x8*)(Ks + QK_LO(d0) + 32 * KROW); }
        __builtin_amdgcn_sched_barrier(0);
#pragma unroll
        for (int d0 = 0; d0 < N; ++d0) {
            p0 = __builtin_amdgcn_mfma_f32_32x32x16_bf16(f0[d0], qr[d0], p0, 0, 0, 0);
            p1 = __builtin_amdgcn_mfma_f32_32x32x16_bf16(f1[d0], qr[d0], p1, 0, 0, 0); }
    } else {
#pragma unroll
        for (int d0 = 0; d0 < N; ++d0) {
            const bf16x8 b0 = *(const LAS bf16x8*)(Ks + QK_LO(d0));
            const bf16x8 b1 = *(const LAS bf16x8*)(Ks + QK_LO(d0) + 32 * KROW);
            p0 = __builtin_amdgcn_mfma_f32_32x32x16_bf16(b0, qr[d0], p0, 0, 0, 0);
            p1 = __builtin_amdgcn_mfma_f32_32x32x16_bf16(b1, qr[d0], p1, 0, 0, 0); }
    }
#undef QK_LO
}
#ifndef FIXMAX
#define FIXMAX 1
#endif
#if FIXMAX
template <bool BIAS, bool NOEXP = false> __device__ __forceinline__ void partialSM(f32x16& p0, f32x16& p1, const LAS float* tb  , bool nearT) {
    if (BIAS && nearT) {
#pragma unroll
        for (int r = 0; r < 16; ++r) { const int ko = (r & 3) + 8 * (r >> 2); p0[r] += tb[ko]; p1[r] += tb[ko + 32]; }
    }
#pragma unroll
    for (int r = 0; r < 16; ++r) p0[r] = NOEXP ? p0[r] * 0.001f : __builtin_amdgcn_exp2f(p0[r]);
}
template <bool NOEXP = false> __device__ __forceinline__ void finishSM(f32x16& p0, f32x16& p1, float& l_reg, bf16x8& pa0, bf16x8& pa1, bf16x8& pa2, bf16x8& pa3) {
#pragma unroll
    for (int r = 0; r < 16; ++r) p1[r] = NOEXP ? p1[r] * 0.001f : __builtin_amdgcn_exp2f(p1[r]);
    float ps = 0.f;
#pragma unroll
    for (int r = 0; r < 16; ++r) ps += p0[r];
#pragma unroll
    for (int r = 0; r < 16; ++r) ps += p1[r];
    l_reg += ps;
#define PK4(P, BASE, OUT) do { unsigned a0 = cvtpk(P[BASE + 0], P[BASE + 1]), a1 = cvtpk(P[BASE + 2], P[BASE + 3]);   \
    unsigned b0_ = cvtpk(P[BASE + 4], P[BASE + 5]), b1_ = cvtpk(P[BASE + 6], P[BASE + 7]);                              \
    auto r0 = __builtin_amdgcn_permlane32_swap(a0, b0_, false, false); auto r1 = __builtin_amdgcn_permlane32_swap(a1, b1_, false, false); \
    v4u w = {r0[0], r1[0], r0[1], r1[1]}; OUT = *reinterpret_cast<bf16x8*>(&w); } while (0)
    PK4(p0, 0, pa0); PK4(p0, 8, pa1); PK4(p1, 0, pa2); PK4(p1, 8, pa3);
#undef PK4
}
#else
template <bool BIAS, bool NOEXP = false> __device__ __forceinline__ void partialSM(f32x16& p0, f32x16& p1, float& m_reg, float& alpha, float C, const LAS float* tabL, int relb  , bool nearT) {
    const bool perElem = BIAS && nearT;
    float bf = 0.f;
    if (perElem) { const LAS float* tb = tabL + relb;
#pragma unroll
        for (int r = 0; r < 16; ++r) { const int ko = (r & 3) + 8 * (r >> 2); p0[r] = fmaf(p0[r], C, tb[ko]); p1[r] = fmaf(p1[r], C, tb[ko + 32]); }
    } else if (BIAS) bf = tabL[0];
    float pmax = p0[0];
#pragma unroll
    for (int r = 1; r < 16; ++r) pmax = fmaxf(pmax, p0[r]);
#pragma unroll
    for (int r = 0; r < 16; ++r) pmax = fmaxf(pmax, p1[r]);
    { auto rr = __builtin_amdgcn_permlane32_swap(__float_as_uint(pmax), __float_as_uint(pmax), false, false);
      pmax = fmaxf(__uint_as_float(rr[0]), __uint_as_float(rr[1])); }
    if (!perElem) pmax = fmaf(pmax, C, bf);
    if (__builtin_expect(__all(pmax - m_reg <= THR2), 1)) { alpha = 1.f; }
    else { const float mn = fmaxf(m_reg, pmax); alpha = __builtin_amdgcn_exp2f(m_reg - mn); m_reg = mn; }
    if (perElem) {
#pragma unroll
        for (int r = 0; r < 16; ++r) { p0[r] -= m_reg; p1[r] -= m_reg; }
    } else { const float sh = bf - m_reg;
#pragma unroll
        for (int r = 0; r < 16; ++r) { p0[r] = fmaf(p0[r], C, sh); p1[r] = fmaf(p1[r], C, sh); }
    }
#pragma unroll
    for (int r = 0; r < 16; ++r) p0[r] = NOEXP ? p0[r] * 0.001f : __builtin_amdgcn_exp2f(p0[r]);
}
template <bool NOEXP = false> __device__ __forceinline__ void finishSM(f32x16& p0, f32x16& p1, float alpha, float& l_reg, bf16x8& pa0, bf16x8& pa1, bf16x8& pa2, bf16x8& pa3) {
#pragma unroll
    for (int r = 0; r < 16; ++r) p1[r] = NOEXP ? p1[r] * 0.001f : __builtin_amdgcn_exp2f(p1[r]);
    float ps = 0.f;
#pragma unroll
    for (int r = 0; r < 16; ++r) ps += p0[r];
#pragma unroll
    for (int r = 0; r < 16; ++r) ps += p1[r];
    { auto rr = __builtin_amdgcn_permlane32_swap(__float_as_uint(ps), __float_as_uint(ps), false, false);
      ps = __uint_as_float(rr[0]) + __uint_as_float(rr[1]); }
    l_reg = l_reg * alpha + ps;
#define PK4(P, BASE, OUT) do { unsigned a0 = cvtpk(P[BASE + 0], P[BASE + 1]), a1 = cvtpk(P[BASE + 2], P[BASE + 3]);   \
    unsigned b0_ = cvtpk(P[BASE + 4], P[BASE + 5]), b1_ = cvtpk(P[BASE + 6], P[BASE + 7]);                              \
    auto r0 = __builtin_amdgcn_permlane32_swap(a0, b0_, false, false); auto r1 = __builtin_amdgcn_permlane32_swap(a1, b1_, false, false); \
    v4u w = {r0[0], r1[0], r0[1], r1[1]}; OUT = *reinterpret_cast<bf16x8*>(&w); } while (0)
    PK4(p0, 0, pa0); PK4(p0, 8, pa1); PK4(p1, 0, pa2); PK4(p1, 8, pa3);
#undef PK4
}

#endif

template <int DQK, bool BIAS, int EPI  , int PIPE  , int ABL = 0, int QPREP = 0  >
__device__ __forceinline__ void attn_unit(const bf16* __restrict__ Qb, int LDQ, const bf16* Kh, int LDK, const bf16* Vh, int LDV,
                                          int q0, float C, float nM2  , float* Of, bf16* __restrict__ Ob, int LDO, LAS unsigned char* lds, float lam = 0.f, const float* subg = nullptr, float post = 1.f, int LDOF = 0) {
    constexpr int KROW = DQK * 2;
    constexpr int SHM_K = KVBLK * KROW;
    constexpr int NKI = SHM_K / 8192;
    constexpr int NVI = SHM_V / 8192;
    static_assert(NVI == 2 && (NKI == 1 || NKI == 3), "vmcnt literals below");
    int tid_ = threadIdx.x; asm volatile("" : "+v"(tid_));
    const int tid = tid_, wid = __builtin_amdgcn_readfirstlane(tid >> 6), lane = tid & 63, r32 = lane & 31, hi = lane >> 5;
    LAS unsigned char* V_lds = lds + OFF_V; LAS unsigned char* K_lds = lds + OFF_K;
    LAS float* ws = (LAS float*)(lds + OFF_WS) + wid * 64; LAS float* li_l = ws; LAS float* al_l = ws + 32;
    const LAS float* tabL = (const LAS float*)(lds + OFF_TAB);
    const int NT = q0 / KVBLK + 4;
    const int my_last = (q0 + wid * 32) / KVBLK;
    const int qw0 = q0 + wid * 32, qpos = qw0 + r32;
    bf16x8 qr[DQK / 16];
#define Q_LOAD_PREP() do { \
    { const bf16* Qw = Qb + (size_t)(wid * 32 + r32) * LDQ + hi * 8; \
_Pragma("unroll") \
      for (int d0 = 0; d0 < DQK / 16; ++d0) qr[d0] = *(const bf16x8*)(Qw + d0 * 16); } \
    if constexpr (QPREP != 0) { \
        const LAS float* gq = (const LAS float*)(lds + OFF_GQ) + (QPREP == 1 ? 0 : 192) + hi * 8; \
        float ss = 0.f; \
_Pragma("unroll") \
        for (int d0 = 0; d0 < DQK / 16; ++d0) { const v4u w = __builtin_bit_cast(v4u, qr[d0]); \
            ss += bflo(w.x) * bflo(w.x) + bfhi(w.x) * bfhi(w.x) + bflo(w.y) * bflo(w.y) + bfhi(w.y) * bfhi(w.y) + bflo(w.z) * bflo(w.z) + bfhi(w.z) * bfhi(w.z) + bflo(w.w) * bflo(w.w) + bfhi(w.w) * bfhi(w.w); } \
        { auto rr = __builtin_amdgcn_permlane32_swap(__float_as_uint(ss), __float_as_uint(ss), false, false); ss = __uint_as_float(rr[0]) + __uint_as_float(rr[1]); } \
        const float rstd = 1.0f / sqrtf(ss * (1.f / DQK) + EPS); \
        constexpr int NPLAIN = QPREP == 1 ? 8 : DQK / 16; \
_Pragma("unroll") \
        for (int d0 = 0; d0 < NPLAIN; ++d0) { const v4u w = __builtin_bit_cast(v4u, qr[d0]); const LAS float* g = gq + d0 * 16; v4u o_; \
            o_.x = pk2(bflo(w.x) * rstd * g[0], bfhi(w.x) * rstd * g[1]); o_.y = pk2(bflo(w.y) * rstd * g[2], bfhi(w.y) * rstd * g[3]); \
            o_.z = pk2(bflo(w.z) * rstd * g[4], bfhi(w.z) * rstd * g[5]); o_.w = pk2(bflo(w.w) * rstd * g[6], bfhi(w.w) * rstd * g[7]); qr[d0] = __builtin_bit_cast(bf16x8, o_); } \
        if constexpr (QPREP == 1) { \
            const float pos = (float)qpos; \
_Pragma("unroll") \
            for (int dd = 0; dd < 2; ++dd) { const v4u w1 = __builtin_bit_cast(v4u, qr[8 + dd]), w2 = __builtin_bit_cast(v4u, qr[10 + dd]); \
                float x1[8] = {bflo(w1.x), bfhi(w1.x), bflo(w1.y), bfhi(w1.y), bflo(w1.z), bfhi(w1.z), bflo(w1.w), bfhi(w1.w)}; \
                float x2[8] = {bflo(w2.x), bfhi(w2.x), bflo(w2.y), bfhi(w2.y), bflo(w2.z), bfhi(w2.z), bflo(w2.w), bfhi(w2.w)}; \
                const LAS float* g1 = gq + (8 + dd) * 16; const LAS float* g2 = gq + (10 + dd) * 16; \
_Pragma("unroll") \
                for (int e = 0; e < 8; ++e) { const int fi = dd * 16 + hi * 8 + e; \
                    const float invf = __builtin_amdgcn_exp2f(-(float)fi * (13.287712379549449f / 32.0f)); \
                    float rev = pos * invf * 0.15915494309189535f; rev -= rintf(rev); const float sn = __builtin_amdgcn_sinf(rev), cs = __builtin_amdgcn_cosf(rev); \
                    const float a = x1[e] * rstd * g1[e], b = x2[e] * rstd * g2[e]; x1[e] = a * cs - b * sn; x2[e] = b * cs + a * sn; } \
                v4u o1, o2; o1.x = pk2(x1[0], x1[1]); o1.y = pk2(x1[2], x1[3]); o1.z = pk2(x1[4], x1[5]); o1.w = pk2(x1[6], x1[7]); \
                o2.x = pk2(x2[0], x2[1]); o2.y = pk2(x2[2], x2[3]); o2.z = pk2(x2[4], x2[5]); o2.w = pk2(x2[6], x2[7]); \
                qr[8 + dd] = __builtin_bit_cast(bf16x8, o1); qr[10 + dd] = __builtin_bit_cast(bf16x8, o2); } \
        } \
    } \
    __builtin_amdgcn_sched_barrier(0); } while (0)
    __builtin_amdgcn_sched_barrier(0);
    const __amdgpu_buffer_rsrc_t rsK = __builtin_amdgcn_make_buffer_rsrc((void*)Kh, (short)0, 0x7FFFFFFF, 0x00020000);
    const __amdgpu_buffer_rsrc_t rsV = __builtin_amdgcn_make_buffer_rsrc((void*)Vh, (short)0, 0x7FFFFFFF, 0x00020000);
    const unsigned ldkb = (unsigned)LDK * 2u, ldvb = (unsigned)LDV * 2u;
    unsigned kvo[NKI], vvo[NVI];
#pragma unroll
    for (int i = 0; i < NKI; ++i) { const int p = (wid * NKI + i) * 1024 + lane * 16, row = p / KROW, ch = (p % KROW) >> 4; kvo[i] = (unsigned)row * ldkb + (unsigned)((ch ^ ((row >> 1) & 7)) << 4); }
#pragma unroll
    for (int i = 0; i < NVI; ++i) { const int p = (wid * NVI + i) * 1024 + lane * 16, sub = p >> 9, within = p & 511, kk = (sub >> 2) * 8 + (within >> 6);
        const int key = (kk & ~0xC) | ((kk & 4) << 1) | ((kk & 8) >> 1), c = (sub & 3) * 32 + ((within & 63) >> 1); vvo[i] = (unsigned)key * ldvb + (unsigned)c * 2u; }
#define DMA_K(slot, tile) do { if constexpr (!(ABL & 16)) _Pragma("unroll") for (int i = 0; i < NKI; ++i) \
    __builtin_amdgcn_raw_ptr_buffer_load_lds(rsK, (LAS void*)(K_lds + (slot) * SHM_K + (wid * NKI + i) * 1024), 16, (int)kvo[i], (int)((unsigned)(tile) * KVBLK * ldkb), 0, 0); } while (0)
#define DMA_V(slot, tile) do { if constexpr (!(ABL & 16)) _Pragma("unroll") for (int i = 0; i < NVI; ++i) \
    __builtin_amdgcn_raw_ptr_buffer_load_lds(rsV, (LAS void*)(V_lds + (slot) * SHM_V + (wid * NVI + i) * 1024), 16, (int)vvo[i], (int)((unsigned)(tile) * KVBLK * ldvb), 0, 0); } while (0)
#define BAR() do { if constexpr (!(ABL & 32)) __builtin_amdgcn_s_barrier(); asm volatile("" ::: "memory"); } while (0)
#define QKT(C0, C1, KP, RELB, NR) do { if constexpr (!(ABL & 8)) qkt<DQK, BIAS>(C0, C1, KP, qr, r32, hi); else { _Pragma("unroll") for (int r_ = 0; r_ < 16; ++r_) { C0[r_] = 0.f; C1[r_] = 0.f; } } } while (0)
#define PVALL(VB) do { if constexpr (!(ABL & 4)) pv_all(o, VB, pa0, pa1, pa2, pa3); } while (0)
#define QKT_V(C0, C1, KP, VB) do { if constexpr (!(ABL & 8)) qkt<DQK, BIAS, true>(C0, C1, KP, qr, r32, hi, VB, &vf); else { _Pragma("unroll") for (int r_ = 0; r_ < 16; ++r_) { C0[r_] = 0.f; C1[r_] = 0.f; } pv_pre(vf, VB); } } while (0)
#define PVALL_PRE(VB) do { if constexpr (!(ABL & 4)) pv_all_pre(o, VB, pa0, pa1, pa2, pa3, vf); } while (0)
#if FIXMAX
#define PSM(C0, C1, ALC, RELB, NR) do { if constexpr (!(ABL & 2)) partialSM<BIAS, (ABL & 1) != 0>(C0, C1, tabL + (RELB), NR); } while (0)
#define FSM(P0, P1, ALP) do { if constexpr (!(ABL & 2)) finishSM<(ABL & 1) != 0>(P0, P1, l_reg, pa0, pa1, pa2, pa3); else { pa0 = __builtin_bit_cast(bf16x8, (f32x4){P0[0], P0[1], P0[2], P0[3]}); pa1 = __builtin_bit_cast(bf16x8, (f32x4){P0[4], P0[5], P0[6], P0[7]}); pa2 = __builtin_bit_cast(bf16x8, (f32x4){P1[0], P1[1], P1[2], P1[3]}); pa3 = __builtin_bit_cast(bf16x8, (f32x4){P1[4], P1[5], P1[6], P1[7]}); } } while (0)
#else
#define PSM(C0, C1, ALC, RELB, NR) do { if constexpr (!(ABL & 2)) partialSM<BIAS, (ABL & 1) != 0>(C0, C1, m_reg, ALC, C, tabL, RELB, NR); } while (0)
#define FSM(P0, P1, ALP) do { if constexpr (!(ABL & 2)) finishSM<(ABL & 1) != 0>(P0, P1, ALP, l_reg, pa0, pa1, pa2, pa3); else { pa0 = __builtin_bit_cast(bf16x8, (f32x4){P0[0], P0[1], P0[2], P0[3]}); pa1 = __builtin_bit_cast(bf16x8, (f32x4){P0[4], P0[5], P0[6], P0[7]}); pa2 = __builtin_bit_cast(bf16x8, (f32x4){P1[0], P1[1], P1[2], P1[3]}); pa3 = __builtin_bit_cast(bf16x8, (f32x4){P1[4], P1[5], P1[6], P1[7]}); } } while (0)
#endif
#if FIXMAX
    float l_reg = 0.f; f32x16 o[4];
#else
    float m_reg = -1e30f, l_reg = 0.f; f32x16 o[4];
#endif
    const int vb0 = (int)(unsigned)(size_t)V_lds + v_rd_base(lane);
    const int relb0 = 192 + 4 * hi - qpos;
#if FIXMAX
#define RESC(a) do { } while (0)
#else
#define RESC(a) do { if (__any((a) < 1.f)) { if (hi == 0) al_l[r32] = (a); asm volatile("s_waitcnt lgkmcnt(0)" ::: "memory"); \
    _Pragma("unroll") for (int r = 0; r < 16; ++r) { const float a_ = al_l[crow(r, hi)]; _Pragma("unroll") for (int d = 0; d < 4; ++d) o[d][r] *= a_; } } } while (0)
#endif
#define NEAR(j) (((j) * KVBLK + 63 - qw0) > -91)
    f32x16 pA0, pA1, pB0, pB1; bf16x8 pa0, pa1, pa2, pa3;
#if !FIXMAX
    float alA = 1.f, alB = 1.f;
#endif
    int vs = 0;
    int j = 1;
    if constexpr (PIPE == 2) {
        const bool halfB = wid >= 4;
        DMA_K(0, 0); DMA_V(0, 0); DMA_K(1, 1); DMA_V(1, 1); DMA_K(2, 2);
        Q_LOAD_PREP();
#pragma unroll
        for (int d = 0; d < 4; ++d)
#pragma unroll
            for (int r = 0; r < 16; ++r) o[d][r] = 0.f;
        asm volatile("s_waitcnt vmcnt(0) lgkmcnt(0)" ::: "memory");
        BAR();
        QKT(pA0, pA1, K_lds, relb0, NEAR(0)); PSM(pA0, pA1, alA, relb0, NEAR(0)); RESC(alA); FSM(pA0, pA1, alA);
#define INC3(x) ((x) == 2 ? 0 : (x) + 1)
#define SYNC_ISSUE(k, ksl, vsl) do { asm volatile("s_waitcnt vmcnt(0)" ::: "memory"); BAR(); \
        if ((k) + 3 < NT) DMA_K(ksl, (k) + 3); if ((k) + 2 < NT) DMA_V(vsl, (k) + 2); } while (0)
        if (!halfB) SYNC_ISSUE(0, 0, 2);
        for (; j <= my_last; ++j) {
            const int ks_ = INC3(vs);
            s16x4 vf[8];
            QKT_V(pA0, pA1, K_lds + ks_ * SHM_K, vb0 + vs * SHM_V);
            PVALL_PRE(vb0 + vs * SHM_V);
            __builtin_amdgcn_sched_barrier(0);
            if (halfB) SYNC_ISSUE(j - 1, vs, INC3(ks_));
            __builtin_amdgcn_sched_barrier(0);
            PSM(pA0, pA1, alA, relb0 + j * KVBLK, NEAR(j)); RESC(alA); FSM(pA0, pA1, alA);
            __builtin_amdgcn_sched_barrier(0);
            if (!halfB) SYNC_ISSUE(j, ks_, vs);
            vs = ks_;
        }
        PVALL(vb0 + vs * SHM_V);
        { int ksl = halfB ? vs : INC3(vs);
          for (int k = halfB ? j - 1 : j; k < NT; ++k) { const int vsl = INC3(INC3(ksl)); SYNC_ISSUE(k, ksl, vsl); ksl = INC3(ksl); } }
#undef SYNC_ISSUE
#undef INC3
    } else if constexpr (PIPE == 1) {
        const bool halfB = wid >= 4;
        DMA_K(0, 0); DMA_V(0, 0); DMA_K(1, 1);
        Q_LOAD_PREP();
#pragma unroll
        for (int d = 0; d < 4; ++d)
#pragma unroll
            for (int r = 0; r < 16; ++r) o[d][r] = 0.f;
        if constexpr (NKI == 3) asm volatile("s_waitcnt vmcnt(3) lgkmcnt(0)" ::: "memory"); else asm volatile("s_waitcnt vmcnt(1) lgkmcnt(0)" ::: "memory");
        BAR();
        QKT(pA0, pA1, K_lds, relb0, NEAR(0)); PSM(pA0, pA1, alA, relb0, NEAR(0)); RESC(alA);
        asm volatile("s_waitcnt vmcnt(0)" ::: "memory"); BAR();
        DMA_K(0, 2); DMA_V(1, 1);
#define SYNC_ISSUE(j, KS) do { asm volatile("s_waitcnt vmcnt(0)" ::: "memory"); BAR(); \
        if ((j) + 2 < NT) DMA_K(KS, (j) + 2); if ((j) + 1 < NT) { int vn_ = vs + 2; vn_ = vn_ >= 3 ? vn_ - 3 : vn_; DMA_V(vn_, (j) + 1); } } while (0)
#define ITER(j, C0, C1, ALC, P0, P1, ALP, KS) do { \
        QKT(C0, C1, K_lds + (KS) * SHM_K, relb0 + (j) * KVBLK, NEAR(j)); \
        FSM(P0, P1, ALP); \
        __builtin_amdgcn_sched_barrier(0); \
        if (halfB) SYNC_ISSUE(j, KS); \
        __builtin_amdgcn_sched_barrier(0); \
        PVALL(vb0 + vs * SHM_V); \
        PSM(C0, C1, ALC, relb0 + (j) * KVBLK, NEAR(j)); RESC(ALC); \
        __builtin_amdgcn_sched_barrier(0); \
        if (!halfB) SYNC_ISSUE(j, KS); \
        vs = vs == 2 ? 0 : vs + 1; } while (0)
        for (; j + 1 <= my_last; j += 2) {
            ITER(j, pB0, pB1, alB, pA0, pA1, alA, 1);
            ITER(j + 1, pA0, pA1, alA, pB0, pB1, alB, 0);
        }
        if (j <= my_last) {
            ITER(j, pB0, pB1, alB, pA0, pA1, alA, 1); ++j;
            FSM(pB0, pB1, alB); __builtin_amdgcn_sched_barrier(0); PVALL(vb0 + vs * SHM_V);
        } else {
            FSM(pA0, pA1, alA); __builtin_amdgcn_sched_barrier(0); PVALL(vb0 + vs * SHM_V);
        }
#undef ITER
        for (; j < NT; ++j) { SYNC_ISSUE(j, j & 1); vs = vs == 2 ? 0 : vs + 1; }
#undef SYNC_ISSUE
    } else {
        DMA_K(0, 0); DMA_V(0, 0); DMA_K(1, 1); DMA_V(1, 1);
        Q_LOAD_PREP();
#pragma unroll
        for (int d = 0; d < 4; ++d)
#pragma unroll
            for (int r = 0; r < 16; ++r) o[d][r] = 0.f;
        if constexpr (NKI == 3) asm volatile("s_waitcnt vmcnt(5) lgkmcnt(0)" ::: "memory"); else asm volatile("s_waitcnt vmcnt(3) lgkmcnt(0)" ::: "memory");
        BAR();
        QKT(pA0, pA1, K_lds, relb0, NEAR(0)); PSM(pA0, pA1, alA, relb0, NEAR(0)); RESC(alA);
        FSM(pA0, pA1, alA); __builtin_amdgcn_sched_barrier(0); PVALL(vb0);
        asm volatile("s_waitcnt vmcnt(0)" ::: "memory"); BAR();
#define ISSUE_NEXT(j, KSN) do { int vn_ = vs + 2; vn_ = vn_ >= 3 ? vn_ - 3 : vn_; DMA_K(KSN, (j) + 1); DMA_V(vn_, (j) + 1); } while (0)
#define END_ITER() do { asm volatile("s_waitcnt vmcnt(0)" ::: "memory"); BAR(); vs = vs == 2 ? 0 : vs + 1; } while (0)
        for (; j <= my_last; ++j) {
            if (j + 1 < NT) ISSUE_NEXT(j, (j + 1) & 1);
            __builtin_amdgcn_sched_barrier(0);
            QKT(pA0, pA1, K_lds + (j & 1) * SHM_K, relb0 + j * KVBLK, NEAR(j));
            PSM(pA0, pA1, alA, relb0 + j * KVBLK, NEAR(j)); RESC(alA);
            FSM(pA0, pA1, alA);
            __builtin_amdgcn_sched_barrier(0);
            { int vc = vs + 1; vc = vc == 3 ? 0 : vc; PVALL(vb0 + vc * SHM_V); }
            END_ITER();
        }
        for (; j < NT; ++j) { if (j + 1 < NT) ISSUE_NEXT(j, (j + 1) & 1); END_ITER(); }
#undef ISSUE_NEXT
#undef END_ITER
    }
    BAR();
#undef DMA_K
#undef DMA_V
#undef RESC
#undef NEAR
#if FIXMAX
    { auto rr = __builtin_amdgcn_permlane32_swap(__float_as_uint(l_reg), __float_as_uint(l_reg), false, false); l_reg = __uint_as_float(rr[0]) + __uint_as_float(rr[1]); }
#endif
    if (hi == 0) li_l[r32] = l_reg;
    asm volatile("s_waitcnt lgkmcnt(0)" ::: "memory");
    float rli[16];
#pragma unroll
    for (int r = 0; r < 16; ++r) rli[r] = __builtin_amdgcn_rcpf(li_l[crow(r, hi)]);
    if constexpr (EPI == 2) {
        float gl[4];
#pragma unroll
        for (int d0 = 0; d0 < 4; ++d0) gl[d0] = subg[d0 * 32 + r32] * post;
#pragma unroll
        for (int r = 0; r < 16; ++r) { const int orow = wid * 32 + crow(r, hi);
            float dv[4]; float ss = 0.f;
#pragma unroll
            for (int d0 = 0; d0 < 4; ++d0) { dv[d0] = Of[(size_t)orow * LDOF + d0 * 32 + r32] - lam * (o[d0][r] * rli[r]); ss += dv[d0] * dv[d0]; }
            ss += __shfl_xor(ss, 1); ss += __shfl_xor(ss, 2); ss += __shfl_xor(ss, 4); ss += __shfl_xor(ss, 8); ss += __shfl_xor(ss, 16);
            const float rstd = 1.0f / sqrtf(ss * (1.f / 128.f) + EPS);
#pragma unroll
            for (int d0 = 0; d0 < 4; ++d0) Ob[(size_t)orow * LDO + d0 * 32 + r32] = (bf16)f2bf(dv[d0] * rstd * gl[d0]); }
    } else {
#pragma unroll
    for (int r = 0; r < 16; ++r) { const int orow = wid * 32 + crow(r, hi);
#pragma unroll
        for (int d0 = 0; d0 < 4; ++d0) { const float v = o[d0][r] * rli[r];
            if (EPI == 1) Of[(size_t)orow * LDO + d0 * 32 + r32] = v; else Ob[(size_t)orow * LDO + d0 * 32 + r32] = (bf16)f2bf(v); } }
    }
#undef BAR
#undef QKT
#undef PVALL
#undef QKT_V
#undef PVALL_PRE
#undef PSM
#undef FSM
#undef Q_LOAD_PREP
}
}

constexpr int NWAVES = 8;
struct Args { const float* in[25]; float* out; unsigned char* ws; int ph_lo, ph_hi; };
struct Frame {
    LAS unsigned char* lds;
    int tid, lane, wave, G, gw, NGW;
    const float* const* in; float* out; unsigned char* ws; unsigned* ctl;
};

__device__ __forceinline__ void p0_transpose_item(const float* W, int K, int N, bf16* WT, LAS float* scr, int item, int lane) {
    const int nblk = N / 32, kb = item / nblk, nb = item % nblk, k0 = 64 * kb, n0 = 32 * nb;
#pragma unroll 8
    for (int i = 0; i < 32; ++i) { const int kk = 2 * i + (lane >> 5); scr[kk * 33 + (lane & 31)] = W[(size_t)(k0 + kk) * N + n0 + (lane & 31)]; }
    LDS_WAIT(); asm volatile("" ::: "memory");
    const int c = lane & 7;
#pragma unroll
    for (int j = 0; j < 4; ++j) { const int n = (lane >> 3) + 8 * j; const LAS float* s = scr + (8 * c) * 33 + n;
        v4u o; o.x = pk2(s[0 * 33], s[1 * 33]); o.y = pk2(s[2 * 33], s[3 * 33]); o.z = pk2(s[4 * 33], s[5 * 33]); o.w = pk2(s[6 * 33], s[7 * 33]);
        *(v4u*)(WT + (size_t)(n0 + n) * K + k0 + 8 * c) = o; }
    LDS_WAIT(); asm volatile("" ::: "memory");
}
__device__ __forceinline__ unsigned pk4_fp8s(float a, float b, float c, float d) {
    a = __builtin_amdgcn_fmed3f(a, 448.0f, -448.0f); b = __builtin_amdgcn_fmed3f(b, 448.0f, -448.0f); c = __builtin_amdgcn_fmed3f(c, 448.0f, -448.0f); d = __builtin_amdgcn_fmed3f(d, 448.0f, -448.0f);
    int w = __builtin_amdgcn_cvt_pk_fp8_f32(a, b, 0, false); w = __builtin_amdgcn_cvt_pk_fp8_f32(c, d, w, true); return (unsigned)w;
}
constexpr float WSCALE = 64.0f, WSCALE_INV = 1.0f / 64.0f;
constexpr int CONV_GU_ITEMS = NE * (DM / 128) * (2 * DFF / 64), CONV_DN_ITEMS = NE * (DFF / 128) * (DM / 64), CONV_WAVE_ITEMS = CONV_GU_ITEMS + CONV_DN_ITEMS, CONV_BLOCK_ITEMS = CONV_WAVE_ITEMS / 8;
__device__ __forceinline__ void conv_item_fp8(const float* W, int N, unsigned char* WT, int K, int k0, int n0, LAS unsigned char* tile, int lane) {
    const int g = lane >> 4, c = lane & 15;
    const float* src = W + (size_t)(k0 + 4 * g) * N + n0 + 4 * c;
    LAS unsigned char* wbase = tile + (4 * c) * 128;
    const int swz = 4 * (c & 7);
#pragma unroll 1
    for (int half = 0; half < 2; ++half) {
        f32x4 v[4][4];
#pragma unroll
        for (int q = 0; q < 4; ++q)
#pragma unroll
            for (int i = 0; i < 4; ++i) v[q][i] = __builtin_nontemporal_load((const f32x4*)(src + (size_t)(64 * half + 16 * q + i) * N));
#pragma unroll
        for (int q = 0; q < 4; ++q) { const int kq = (16 * half + 4 * q + g) ^ swz;
#pragma unroll
            for (int j = 0; j < 4; ++j) *(LAS unsigned*)(wbase + j * 128 + kq * 4) = pk4_fp8s(v[q][0][j] * WSCALE, v[q][1][j] * WSCALE, v[q][2][j] * WSCALE, v[q][3][j] * WSCALE); }
    }
    LDS_WAIT(); asm volatile("" ::: "memory");
    const int m = lane & 7;
#pragma unroll
    for (int it = 0; it < 8; ++it) { const int row = (lane >> 3) + 8 * it;
        const v4u x = *(const LAS v4u*)(tile + row * 128 + ((m ^ ((row >> 2) & 7)) * 16));
        st16_wt(WT + (size_t)(n0 + row) * K + k0 + m * 16, x); }
    LDS_WAIT(); asm volatile("" ::: "memory");
}
__device__ __forceinline__ void conv_block_item(Frame& F, int bitem) {
    int lane = F.lane; asm volatile("" : "+v"(lane));
    int id = bitem * 8 + F.wave;
    LAS unsigned char* tile = F.lds + RING_OFF + F.wave * 8192;
    if (id < CONV_GU_ITEMS) { const int e = id >> 10, r = id & 1023, kb = r >> 6, nb = r & 63;
        conv_item_fp8(F.in[20] + (size_t)e * DM * 2 * DFF, 2 * DFF, F.ws + WS_WGU + (size_t)e * 2 * DFF * DM, DM, kb * 128, nb * 64, tile, lane); }
    else { id -= CONV_GU_ITEMS; const int e = id >> 9, r = id & 511, kb = r >> 5, nb = r & 31;
        conv_item_fp8(F.in[22] + (size_t)e * DFF * DM, DM, F.ws + WS_WDN + (size_t)e * DM * DFF, DFF, kb * 128, nb * 64, tile, lane); }
}
__device__ __forceinline__ bool conv_claim(Frame& F, int n) {
    volatile LAS int* ubox = (volatile LAS int*)(F.lds + MISC_UNIT);
    if (F.tid == 0) ubox[1] = (int)__hip_atomic_fetch_add(F.ctl + CW_CONV, (unsigned)n, __ATOMIC_RELAXED, __HIP_MEMORY_SCOPE_AGENT);
    __syncthreads();
    const int b0 = ubox[1];
    __syncthreads();
    for (int b = b0; b < b0 + n && b < CONV_BLOCK_ITEMS; ++b) conv_block_item(F, b);
    return b0 + n < CONV_BLOCK_ITEMS;
}
__device__ __forceinline__ void rms_row_to_bf16(const float* xrow, const float* w, bf16* orow, int lane) {
    const f32x4* xr = (const f32x4*)xrow + lane; const f32x4* wr = (const f32x4*)w + lane;
    f32x4 v[8]; float s = 0.f;
#pragma unroll
    for (int j = 0; j < 8; ++j) { v[j] = xr[64 * j]; s += (v[j].x * v[j].x + v[j].y * v[j].y) + (v[j].z * v[j].z + v[j].w * v[j].w); }
    const float rstd = 1.0f / sqrtf(wave_sum(s) * (1.f / DM) + EPS);
    v2u* o8 = (v2u*)orow + lane;
#pragma unroll
    for (int j = 0; j < 8; ++j) { const f32x4 g = wr[64 * j]; v2u o; o.x = pk2(v[j].x * rstd * g.x, v[j].y * rstd * g.y); o.y = pk2(v[j].z * rstd * g.z, v[j].w * rstd * g.w); o8[64 * j] = o; }
}

__device__ __forceinline__ void rms_row_to_fp8(const float* xrow, const float* w, unsigned char* orow, int lane) {
    const f32x4* xr = (const f32x4*)xrow + lane; const f32x4* wr = (const f32x4*)w + lane;
    f32x4 v[8]; float s = 0.f;
#pragma unroll
    for (int j = 0; j < 8; ++j) { v[j] = xr[64 * j]; s += (v[j].x * v[j].x + v[j].y * v[j].y) + (v[j].z * v[j].z + v[j].w * v[j].w); }
    const float rstd = 1.0f / sqrtf(wave_sum(s) * (1.f / DM) + EPS);
    unsigned* o4 = (unsigned*)orow + lane;
#pragma unroll
    for (int j = 0; j < 8; ++j) { const f32x4 g = wr[64 * j]; o4[64 * j] = pk4_fp8s(v[j].x * rstd * g.x, v[j].y * rstd * g.y, v[j].z * rstd * g.z, v[j].w * rstd * g.w); }
}
#ifndef INPROJ_FP8
#define INPROJ_FP8 0
#endif
__device__ __forceinline__ void p0_prologue(Frame& F) {
    LAS float* scr = (LAS float*)(F.lds + RING_OFF + F.wave * 16384);
    const float* w_in = F.in[2]; const float* w_uq = F.in[4]; const float* w_ukv = F.in[6]; const float* w_o = F.in[16];
    bf16* WIN = (bf16*)(F.ws + WS_WIN); bf16* WUQ = (bf16*)(F.ws + WS_WUQ); bf16* WUKV = (bf16*)(F.ws + WS_WUKV); bf16* WO = (bf16*)(F.ws + WS_WO);
    constexpr int I_IN = (DM / 64) * (INW / 32), I_UQ = (QRANK / 64) * (MH * QKD / 32), I_UKV = (KVRANK / 64) * (MH * 256 / 32), I_O = (DM / 64) * (DM / 32);
#if INPROJ_FP8
    constexpr int I_IN8 = (DM / 128) * (INW / 64);
    constexpr int NITEMS = I_IN8 + I_UQ + I_UKV + I_O;
    for (int it = F.gw; it < NITEMS; it += F.NGW) {
        int r = it;
        if (r < I_IN8) { conv_item_fp8(w_in, INW, F.ws + WS_WIN, DM, (r / (INW / 64)) * 128, (r % (INW / 64)) * 64, F.lds + RING_OFF + F.wave * 16384, F.lane); continue; } r -= I_IN8;
#else
    constexpr int NITEMS = I_IN + I_UQ + I_UKV + I_O;
    for (int it = F.gw; it < NITEMS; it += F.NGW) {
        int r = it;
        if (r < I_IN) { p0_transpose_item(w_in, DM, INW, WIN, scr, r, F.lane); continue; } r -= I_IN;
#endif
        if (r < I_UQ) { p0_transpose_item(w_uq, QRANK, MH * QKD, WUQ, scr, r, F.lane); continue; } r -= I_UQ;
        if (r < I_UKV) { p0_transpose_item(w_ukv, KVRANK, MH * 256, WUKV, scr, r, F.lane); continue; } r -= I_UKV;
        p0_transpose_item(w_o, DM, DM, WO, scr, r, F.lane);
    }
    { v4u* z = (v4u*)((unsigned char*)WIN + (size_t)INW * DM * (INPROJ_FP8 ? 1 : 2)); const int n16 = (INWP - INW) * DM * (INPROJ_FP8 ? 1 : 2) / 16;
      for (int i = blockIdx.x * 512 + F.tid; i < n16; i += F.G * 512) z[i] = (v4u){0u, 0u, 0u, 0u}; }
    { const float* x = F.in[0]; const float* w = F.in[1]; bf16* H = (bf16*)(F.ws + WS_H);
      const int lane = F.lane; f32x4 g[8], cur[8], nxt[8];
#pragma unroll
      for (int j = 0; j < 8; ++j) g[j] = ((const f32x4*)w + lane)[64 * j];
      int m = F.gw;
      if (m < NTOK) {
#pragma unroll
          for (int j = 0; j < 8; ++j) cur[j] = ((const f32x4*)(x + (size_t)m * DM) + lane)[64 * j]; }
      for (; m < NTOK; m += F.NGW) {
          const int mn = m + F.NGW;
          if (mn < NTOK) {
#pragma unroll
              for (int j = 0; j < 8; ++j) nxt[j] = ((const f32x4*)(x + (size_t)mn * DM) + lane)[64 * j]; }
          float sq = 0.f;
#pragma unroll
          for (int j = 0; j < 8; ++j) sq += (cur[j].x * cur[j].x + cur[j].y * cur[j].y) + (cur[j].z * cur[j].z + cur[j].w * cur[j].w);
          const float rstd = 1.0f / sqrtf(wave_sum(sq) * (1.f / DM) + EPS);
          v2u* o8 = (v2u*)(H + (size_t)m * DM) + lane;
#pragma unroll
          for (int j = 0; j < 8; ++j) { v2u o; o.x = pk2(cur[j].x * rstd * g[j].x, cur[j].y * rstd * g[j].y); o.y = pk2(cur[j].z * rstd * g[j].z, cur[j].w * rstd * g[j].w); o8[64 * j] = o; }
#pragma unroll
          for (int j = 0; j < 8; ++j) cur[j] = nxt[j];
      } }
    { const float* fw = F.in[17]; const float* rw = F.in[18]; float* RW = (float*)(F.ws + WS_RW);
      for (int i = blockIdx.x * 512 + F.tid; i < DM * NE; i += F.G * 512) RW[i] = fw[i >> 5] * rw[i]; }
}

__device__ __forceinline__ void unpack8(const v4u w, float (&f)[8]) { f[0] = bflo(w.x); f[1] = bfhi(w.x); f[2] = bflo(w.y); f[3] = bfhi(w.y); f[4] = bflo(w.z); f[5] = bfhi(w.z); f[6] = bflo(w.w); f[7] = bfhi(w.w); }
__device__ __forceinline__ v4u pack8(const float (&f)[8]) { v4u w; w.x = pk2(f[0], f[1]); w.y = pk2(f[2], f[3]); w.z = pk2(f[4], f[5]); w.w = pk2(f[6], f[7]); return w; }
__device__ __forceinline__ void p2_prep1(Frame& F) {
    const bf16* PROJ = (const bf16*)(F.ws + WS_PROJ);
    bf16* AQ = (bf16*)(F.ws + WS_AQ); bf16* AKV = (bf16*)(F.ws + WS_AKV); bf16* DQN = (bf16*)(F.ws + WS_DQN); bf16* DKN = (bf16*)(F.ws + WS_DKN);
    const float* qaw = F.in[3]; const float* kvaw = F.in[5]; const float* dqw = F.in[9]; const float* dkw = F.in[10];
    const int lane = F.lane;
    const bool actq = lane < 48, actkv = lane < 32;
    float gqa[8], gkva[8], gdq[8], gdk[8];
#pragma unroll
    for (int i = 0; i < 8; ++i) { gqa[i] = qaw[(actq ? lane : 0) * 8 + i]; gkva[i] = kvaw[(actkv ? lane : 0) * 8 + i]; gdq[i] = 0.f; gdk[i] = dkw[(lane & 7) * 8 + i]; }
#define P2_LOAD(T, R) do { const bf16* row_ = PROJ + (size_t)(T) * INWP; \
        R[0] = actq ? *(const v4u*)(row_ + C_CQ + lane * 8) : (v4u){0u, 0u, 0u, 0u}; R[1] = actkv ? *(const v4u*)(row_ + C_CKV + lane * 8) : (v4u){0u, 0u, 0u, 0u}; \
        R[2] = lane < 8 ? *(const v4u*)(row_ + C_KR + lane * 8) : (v4u){0u, 0u, 0u, 0u}; R[4] = *(const v4u*)(row_ + C_DK + lane * 8); R[5] = *(const v4u*)(row_ + C_DK + 512 + lane * 8); } while (0)
    v4u cur[6], nxt[6];
    int t = F.gw;
    if (t < NTOK) P2_LOAD(t, cur);
    for (; t < NTOK; t += F.NGW) {
        const int tn = t + F.NGW;
        if (tn < NTOK) P2_LOAD(tn, nxt);
        { float f[8]; unpack8(cur[0], f); float s = 0.f;
#pragma unroll
          for (int i = 0; i < 8; ++i) s += f[i] * f[i];
          const float rstd = 1.0f / sqrtf(wave_sum(s) * (1.f / QRANK) + EPS);
          if (actq) {
#pragma unroll
            for (int i = 0; i < 8; ++i) f[i] = f[i] * rstd * gqa[i];
            st16_wt(AQ + (size_t)t * QRANK + lane * 8, pack8(f)); } }
        { float f[8]; unpack8(cur[1], f); float s = 0.f;
#pragma unroll
          for (int i = 0; i < 8; ++i) s += f[i] * f[i];
          const float rstd = 1.0f / sqrtf(wave_sum(s) * (1.f / KVRANK) + EPS);
          if (actkv) {
#pragma unroll
            for (int i = 0; i < 8; ++i) f[i] = f[i] * rstd * gkva[i];
            st16_wt(AKV + (size_t)t * KVRANK + lane * 8, pack8(f)); } }
        { float f[8]; unpack8(cur[2], f); float s = 0.f;
#pragma unroll
          for (int i = 0; i < 8; ++i) s += f[i] * f[i];
          s += __shfl_xor(s, 1); s += __shfl_xor(s, 2); s += __shfl_xor(s, 4);
          if (lane == 0) ((float*)(F.ws + WS_DQN))[t] = s; }
#pragma unroll
        for (int w4 = 2; w4 < 4; ++w4) { const int which = w4 >> 1, half = w4 & 1;
            float f[8]; unpack8(cur[2 + w4], f); float s = 0.f;
#pragma unroll
            for (int i = 0; i < 8; ++i) s += f[i] * f[i];
            s += __shfl_xor(s, 1); s += __shfl_xor(s, 2); s += __shfl_xor(s, 4);
            const float rstd = 1.0f / sqrtf(s * (1.f / DHD) + EPS);
#pragma unroll
            for (int i = 0; i < 8; ++i) f[i] = f[i] * rstd * (which ? gdk[i] : gdq[i]);
            st16_wt((which ? DKN : DQN) + (size_t)t * 1024 + (half * 64 + lane) * 8, pack8(f)); }
#pragma unroll
        for (int i = 0; i < 6; ++i) cur[i] = nxt[i];
    }
#undef P2_LOAD
}

__device__ __forceinline__ void p4_prep2(Frame& F) {
    const bf16* PROJ = (const bf16*)(F.ws + WS_PROJ); const bf16* QF = (const bf16*)(F.ws + WS_QF); const bf16* KVF = (const bf16*)(F.ws + WS_KVF);
    bf16* QM = (bf16*)(F.ws + WS_QM); bf16* KM = (bf16*)(F.ws + WS_KM);
    const float* qnw = F.in[7]; const float* knw = F.in[8];
    const int lane = F.lane, l32 = lane & 31, sub = lane >> 5;
    const int m = l32 - 16;
    float gq[8], gk[8];
#pragma unroll
    for (int i = 0; i < 8; ++i) { const int idx = l32 < 16 ? l32 * 8 + i : (l32 < 24 ? (i < 4 ? NOPE + 4 * m + i : NOPE + 32 + 4 * m + (i - 4)) : 0); gq[i] = qnw[idx] * (0.07216878364870322f * LOG2E); gk[i] = knw[idx]; }
    float invf[4];
#pragma unroll
    for (int i = 0; i < 4; ++i) invf[i] = __builtin_amdgcn_exp2f(-(float)(4 * (m & 7) + i) * (13.287712379549449f / 32.0f));
    for (int t = F.gw; t < NTOK; t += F.NGW) {
        const int pos = t & (SEQ - 1);
        v4u raw[8];
#pragma unroll
        for (int it = 4; it < 8; ++it) { const int which = it >> 2, h = ((it & 3) << 1) + sub;
            if (l32 < 16) { const bf16* src = which ? (KVF + (size_t)t * 2048 + h * 256 + l32 * 8) : (QF + (size_t)t * 1536 + h * QKD + l32 * 8); raw[it] = *(const v4u*)src; }
            else if (l32 < 24) { const bf16* src = which ? (PROJ + (size_t)t * INWP + C_KR) : (QF + (size_t)t * 1536 + h * QKD + NOPE);
                const v2u a = *(const v2u*)(src + 4 * m), b = *(const v2u*)(src + 32 + 4 * m); raw[it] = (v4u){a.x, a.y, b.x, b.y}; }
            else raw[it] = (v4u){0u, 0u, 0u, 0u}; }
        float sn[4], cs[4];
#pragma unroll
        for (int i = 0; i < 4; ++i) { const float ang = (float)pos * invf[i]; float rev = ang * 0.15915494309189535f; rev -= rintf(rev); sn[i] = __builtin_amdgcn_sinf(rev); cs[i] = __builtin_amdgcn_cosf(rev); }
#pragma unroll
        for (int it = 4; it < 8; ++it) { const int which = it >> 2, h = ((it & 3) << 1) + sub;
            float f[8]; unpack8(raw[it], f);
            float s = 0.f;
#pragma unroll
            for (int i = 0; i < 8; ++i) s += f[i] * f[i];
            s += __shfl_xor(s, 1); s += __shfl_xor(s, 2); s += __shfl_xor(s, 4); s += __shfl_xor(s, 8); s += __shfl_xor(s, 16);
            const float rstd = 1.0f / sqrtf(s * (1.f / QKD) + EPS);
            bf16* dst = (which ? KM : QM) + (size_t)t * 1536 + h * QKD;
            if (l32 < 16) {
#pragma unroll
                for (int i = 0; i < 8; ++i) f[i] = f[i] * rstd * (which ? gk[i] : gq[i]);
                *(v4u*)(dst + l32 * 8) = pack8(f);
            } else if (l32 < 24) { float o1[4], o2[4];
#pragma unroll
                for (int i = 0; i < 4; ++i) { const float x1 = f[i] * rstd * (which ? gk[i] : gq[i]), x2 = f[4 + i] * rstd * (which ? gk[4 + i] : gq[4 + i]);
                    o1[i] = x1 * cs[i] - x2 * sn[i]; o2[i] = x2 * cs[i] + x1 * sn[i]; }
                v2u a, b; a.x = pk2(o1[0], o1[1]); a.y = pk2(o1[2], o1[3]); b.x = pk2(o2[0], o2[1]); b.y = pk2(o2[2], o2[3]);
                *(v2u*)(dst + NOPE + 4 * m) = a; *(v2u*)(dst + NOPE + 32 + 4 * m) = b;
            }
        }
    }
}

__device__ __forceinline__ int t5_bucket(int rel) {
    const int n = rel < 0 ? -rel : rel;
    int b = n < 8 ? n : (n < 12 ? 8 : (n < 16 ? 9 : (n < 23 ? 10 : (n < 32 ? 11 : (n < 46 ? 12 : (n < 64 ? 13 : (n < 91 ? 14 : 15)))))));
    return b + (rel > 0 ? 16 : 0);
}
__device__ __forceinline__ void p5_attention(Frame& F, int rep = 0) {
    const bf16* QM = (const bf16*)(F.ws + WS_QM); const bf16* KM = (const bf16*)(F.ws + WS_KM); const bf16* KVF = (const bf16*)(F.ws + WS_KVF);
    const bf16* DQN = (const bf16*)(F.ws + WS_DQN); const bf16* DKN = (const bf16*)(F.ws + WS_DKN); const bf16* PROJ = (const bf16*)(F.ws + WS_PROJ);
    float* OD = (float*)(F.ws + WS_OD); bf16* Y = (bf16*)(F.ws + WS_Y);
    const float* rel_bias = F.in[24];
    volatile LAS int* ubox = (volatile LAS int*)(F.lds + MISC_UNIT);
    LAS float* tabL = (LAS float*)(F.lds + att::OFF_TAB);
    const int myx = (int)(xb_xcc_id() & 7u);
    if (F.tid < 256) ((LAS float*)(F.lds + att::OFF_GQ))[F.tid] = F.tid < 192 ? F.in[7][F.tid] * (0.07216878364870322f * LOG2E) : F.in[9][F.tid - 192] * (0.125f * LOG2E);
    __syncthreads();
    const bf16* QF = (const bf16*)(F.ws + WS_QF);
    float lam; const float post = 1.0f - (0.8f - 0.6f * 1.0f);
    { const float d1 = wave_sum(F.in[11][F.lane] * F.in[12][F.lane]), d2 = wave_sum(F.in[13][F.lane] * F.in[14][F.lane]); lam = expf(d1) - expf(d2) + (0.8f - 0.6f * 1.0f); }
    constexpr int COST_PER_ITEM = 950;
    int carry = 0; bool more = true;
    for (int k = 0; k < 8; ++k) {
        const int qx = (myx + k) & 7;
        for (;;) {
            if (F.tid == 0) ubox[0] = (int)__hip_atomic_fetch_add(F.ctl + CW_AQ + (rep * 8 + qx) * CW_AQ_STRIDE, 1u, __ATOMIC_RELAXED, __HIP_MEMORY_SCOPE_AGENT);
            __syncthreads();
            const int item = __builtin_amdgcn_readfirstlane(ubox[0]);
            __syncthreads();
            if (item >= 128) break;
            const int qb = 31 - item / 4, kk = item % 4;
#ifndef ATT_ABL
#define ATT_ABL 0
#endif
#ifndef ATT_PROBE_WHICH
#define ATT_PROBE_WHICH 3
#endif
            if (kk < 2) {
                const int s = qx * 2 + kk, b = s >> 3, h = s & 7; const size_t tok0 = (size_t)b * SEQ + (size_t)qb * 256, tokb = (size_t)b * SEQ;
                if (rep == 0) att::attn_unit<QKD, false, 0, 2, 0, 1>(QF + tok0 * 1536 + h * QKD, 1536, KM + tokb * 1536 + h * QKD, 1536, KVF + tokb * 2048 + h * 256 + 128, 2048,
                                                  qb * 256, 0.07216878364870322f * LOG2E, 0.f, nullptr, Y + tok0 * 2048 + h * VD, 2048, F.lds);
                else if (ATT_PROBE_WHICH & 1) att::attn_unit<QKD, false, 0, 2, ATT_ABL, 1>(QF + tok0 * 1536 + h * QKD, 1536, KM + tokb * 1536 + h * QKD, 1536, KVF + tokb * 2048 + h * 256 + 128, 2048,
                                                  qb * 256, 0.07216878364870322f * LOG2E, 0.f, nullptr, (bf16*)(F.ws + WS_XG) + tok0 * 2048 + h * VD, 2048, F.lds);
                carry += (qb + 1) * 320;
            } else {
                const int d = qx * 2 + (kk - 2), b = d >> 3, h = d & 7; const size_t tok0 = (size_t)b * SEQ + (size_t)qb * 256, tokb = (size_t)b * SEQ;
                if (F.tid < 256) tabL[F.tid] = (rel_bias[t5_bucket(F.tid - 192) * DH + h] - rel_bias[t5_bucket(-192) * DH + h]) * LOG2E;
                float* O0 = OD + tok0 * 1024 + h * 128;
                if (rep == 0) {
                    att::attn_unit<DHD, true, 1, 1, 0, 2>(PROJ + tok0 * INWP + C_DQ + h * 128, INWP, DKN + tokb * 1024 + h * 128, 1024, PROJ + tokb * INWP + C_DV + h * 128, INWP,
                                                qb * 256, 0.125f * LOG2E, 0.f, O0, nullptr, 1024, F.lds);
                    att::attn_unit<DHD, true, 2, 1, 0, 2>(PROJ + tok0 * INWP + C_DQ + h * 128 + 64, INWP, DKN + tokb * 1024 + h * 128 + 64, 1024, PROJ + tokb * INWP + C_DV + h * 128, INWP,
                                                qb * 256, 0.125f * LOG2E, 0.f, O0, Y + tok0 * 2048 + 1024 + h * 128, 2048, F.lds, lam, F.in[15], post, 1024);
                } else if (ATT_PROBE_WHICH & 2) { for (int c = 0; c < 2; ++c) att::attn_unit<DHD, true, 1, 1, ATT_ABL, 2>(PROJ + tok0 * INWP + C_DQ + h * 128 + c * 64, INWP, DKN + tokb * 1024 + h * 128 + c * 64, 1024, PROJ + tokb * INWP + C_DV + h * 128, INWP,
                                                qb * 256, 0.125f * LOG2E, 0.f, (float*)(F.ws + WS_XG) + ((size_t)c * NTOK + tok0) * 1024 + h * 128, nullptr, 1024, F.lds); }
                carry += (qb + 1) * 384;
            }
            if (rep == 0 && more && carry >= COST_PER_ITEM) { const int n = carry / COST_PER_ITEM; carry -= n * COST_PER_ITEM; more = conv_claim(F, n); }
        }
    }
    if (rep == 0) while (more) more = conv_claim(F, 1);
}

__device__ __forceinline__ void p6_diffcombine(Frame& F) {
    const float* OD = (const float*)(F.ws + WS_OD); bf16* Y = (bf16*)(F.ws + WS_Y);
    const float* lq1 = F.in[11]; const float* lk1 = F.in[12]; const float* lq2 = F.in[13]; const float* lk2 = F.in[14]; const float* sw = F.in[15];
    const int lane = F.lane;
    const float d1 = wave_sum(lq1[lane] * lk1[lane]), d2 = wave_sum(lq2[lane] * lk2[lane]);
    const float lambda_init = 0.8f - 0.6f * 1.0f;
    const float lam = expf(d1) - expf(d2) + lambda_init;
    const float post = 1.0f - lambda_init;
    const f32x4 g = *(const f32x4*)(sw + (lane & 31) * 4);
    f32x4 ca[4], cb[4], na[4], nb[4];
    int t = F.gw;
    if (t < NTOK) {
#pragma unroll
        for (int q = 0; q < 4; ++q) { ca[q] = *((const f32x4*)(OD + (size_t)t * 1024) + q * 64 + lane); cb[q] = *((const f32x4*)(OD + ((size_t)NTOK + t) * 1024) + q * 64 + lane); } }
    for (; t < NTOK; t += F.NGW) {
        const int tn = t + F.NGW;
        if (tn < NTOK) {
#pragma unroll
            for (int q = 0; q < 4; ++q) { na[q] = *((const f32x4*)(OD + (size_t)tn * 1024) + q * 64 + lane); nb[q] = *((const f32x4*)(OD + ((size_t)NTOK + tn) * 1024) + q * 64 + lane); } }
#pragma unroll
        for (int q = 0; q < 4; ++q) {
            const f32x4 o = ca[q] - lam * cb[q];
            float s = (o.x * o.x + o.y * o.y) + (o.z * o.z + o.w * o.w);
            s += __shfl_xor(s, 1); s += __shfl_xor(s, 2); s += __shfl_xor(s, 4); s += __shfl_xor(s, 8); s += __shfl_xor(s, 16);
            const float rstd = 1.0f / sqrtf(s * (1.f / 128.f) + EPS) * post;
            v2u w; w.x = pk2(o.x * rstd * g.x, o.y * rstd * g.y); w.y = pk2(o.z * rstd * g.z, o.w * rstd * g.w);
            *((v2u*)(Y + (size_t)t * 2048 + 1024) + q * 64 + lane) = w;
        }
#pragma unroll
        for (int q = 0; q < 4; ++q) { ca[q] = na[q]; cb[q] = nb[q]; }
    }
}

__device__ __forceinline__ void p8_router(Frame& F, int rep = 0) {
#if X1_BF16
    const bf16* X1 = (const bf16*)(F.ws + WS_XG);
#else
    const float* X1 = F.out;
#endif
    const float* RW = (const float*)(F.ws + WS_RW); const float* rb = F.in[19]; const float* fw = F.in[17];
    unsigned char* H2 = F.ws + WS_H2;
    int* asg_e = (int*)(F.ws + WS_ASG); int* asg_r = asg_e + NASG; float* asg_g = (float*)(asg_r + NASG);
    LAS float* red = (LAS float*)(F.lds + RING_OFF);
    LAS float* ssq = (LAS float*)(F.lds + RING_OFF + 32768);
    LAS float* lg = (LAS float*)(F.lds + RING_OFF + 32768 + 2048);
    LAS float* rs = (LAS float*)(F.lds + RING_OFF + 32768 + 2048 + 4352);
    LAS unsigned* lcnt = (LAS unsigned*)(F.lds + RING_OFF + 32768 + 2048 + 4352 + 128);
    LAS unsigned* lbase = lcnt + 32;
    const int lane = F.lane, w = F.wave, i = lane & 31, kh = lane >> 5;
    for (int unit = blockIdx.x; unit < NTOK / 32; unit += F.G) {
        const int tok0 = unit * 32;
        f32x16 acc;
#pragma unroll
        for (int r = 0; r < 16; ++r) acc[r] = 0.f;
        float sq = 0.f;
        const auto* xr = X1 + (size_t)(tok0 + i) * DM + w * 256 + 4 * kh;
        const float* rwp = RW + (size_t)(w * 256 + 4 * kh) * NE + i;
#pragma unroll 16
        for (int m = 0; m < 32; ++m) {
#if X1_BF16
            const v2u raw_ = *(const v2u*)(xr + 8 * m); const f32x4 a4 = {bflo(raw_.x), bfhi(raw_.x), bflo(raw_.y), bfhi(raw_.y)};
#else
            const f32x4 a4 = *(const f32x4*)(xr + 8 * m);
#endif
            sq += (a4.x * a4.x + a4.y * a4.y) + (a4.z * a4.z + a4.w * a4.w);
            const float* bp = rwp + (size_t)(8 * m) * NE;
            acc = __builtin_amdgcn_mfma_f32_32x32x2f32(a4.x, bp[0 * NE], acc, 0, 0, 0);
            acc = __builtin_amdgcn_mfma_f32_32x32x2f32(a4.y, bp[1 * NE], acc, 0, 0, 0);
            acc = __builtin_amdgcn_mfma_f32_32x32x2f32(a4.z, bp[2 * NE], acc, 0, 0, 0);
            acc = __builtin_amdgcn_mfma_f32_32x32x2f32(a4.w, bp[3 * NE], acc, 0, 0, 0);
        }
#pragma unroll
        for (int r = 0; r < 16; ++r) red[(w * 32 + ((r & 3) + 8 * (r >> 2) + 4 * kh)) * 32 + i] = acc[r];
        ssq[w * 64 + lane] = sq;
        __syncthreads();
        for (int idx = F.tid; idx < 1024; idx += 512) { float s = 0.f;
#pragma unroll
            for (int ww = 0; ww < 8; ++ww) s += red[ww * 1024 + idx];
            lg[(idx >> 5) * 33 + (idx & 31)] = s; }
        if (F.tid < 32) { float s = 0.f;
#pragma unroll
            for (int ww = 0; ww < 8; ++ww) s += ssq[ww * 64 + F.tid] + ssq[ww * 64 + 32 + F.tid];
            rs[F.tid] = 1.0f / sqrtf(s * (1.f / DM) + EPS); }
        __syncthreads();
        if (F.tid < 32) {
            const int t = tok0 + F.tid; const float rstd = rs[F.tid];
            float v[NE];
#pragma unroll
            for (int e = 0; e < NE; ++e) v[e] = rstd * lg[F.tid * 33 + e] + rb[e];
            int sel[TOPK]; float sv[TOPK];
#pragma unroll
            for (int k = 0; k < TOPK; ++k) { float best = -3.0e38f; int bi = 0;
#pragma unroll
                for (int e = 0; e < NE; ++e) { const bool tk = v[e] > best; best = tk ? v[e] : best; bi = tk ? e : bi; }
                sel[k] = bi; sv[k] = best;
#pragma unroll
                for (int e = 0; e < NE; ++e) v[e] = (e == bi) ? -3.0e38f : v[e]; }
            float den = 0.f, ex[TOPK];
#pragma unroll
            for (int k = 0; k < TOPK; ++k) { ex[k] = expf(sv[k] - sv[0]); den += ex[k]; }
            const float rden = 1.0f / den;
            lcnt[F.tid] = 0;
            LDS_WAIT(); asm volatile("" ::: "memory");
            int lr[TOPK];
#pragma unroll
            for (int k = 0; k < TOPK; ++k) lr[k] = (int)__hip_atomic_fetch_add((LAS unsigned*)lcnt + sel[k], 1u, __ATOMIC_RELAXED, __HIP_MEMORY_SCOPE_WORKGROUP);
            LDS_WAIT(); asm volatile("" ::: "memory");
            ((int*)(F.ws + WS_UCNT))[unit * NE + F.tid] = (int)((volatile LAS unsigned*)lcnt)[F.tid];
#pragma unroll
            for (int k = 0; k < TOPK; ++k) { asg_e[t * TOPK + k] = sel[k]; asg_r[t * TOPK + k] = lr[k]; asg_g[t * TOPK + k] = ex[k] * rden; }
        }
#pragma unroll 1
        for (int q = 0; q < 4; q += 2) { const int tl = w * 4 + q; const float rstd0 = rs[tl], rstd1 = rs[tl + 1];
#if X1_BF16
            const v2u* xa = (const v2u*)(X1 + (size_t)(tok0 + tl) * DM) + lane; const v2u* xb = xa + DM / 4;
#else
            const f32x4* xa = (const f32x4*)(X1 + (size_t)(tok0 + tl) * DM) + lane; const f32x4* xb = xa + DM / 4;
#endif
            const f32x4* wr4 = (const f32x4*)fw + lane;
            unsigned* oa = (unsigned*)(H2 + (size_t)(tok0 + tl) * DM) + lane; unsigned* ob = oa + DM / 4;
            f32x4 va[8], vb[8];
#pragma unroll
#if X1_BF16
            for (int j = 0; j < 8; ++j) { const v2u ra = xa[64 * j], rb_ = xb[64 * j]; va[j] = (f32x4){bflo(ra.x), bfhi(ra.x), bflo(ra.y), bfhi(ra.y)}; vb[j] = (f32x4){bflo(rb_.x), bfhi(rb_.x), bflo(rb_.y), bfhi(rb_.y)}; }
#else
            for (int j = 0; j < 8; ++j) { va[j] = xa[64 * j]; vb[j] = xb[64 * j]; }
#endif
#pragma unroll
            for (int j = 0; j < 8; ++j) { const f32x4 g = wr4[64 * j];
                oa[64 * j] = pk4_fp8s(va[j].x * rstd0 * g.x, va[j].y * rstd0 * g.y, va[j].z * rstd0 * g.z, va[j].w * rstd0 * g.w);
                ob[64 * j] = pk4_fp8s(vb[j].x * rstd1 * g.x, vb[j].y * rstd1 * g.y, vb[j].z * rstd1 * g.z, vb[j].w * rstd1 * g.w); } }
        __syncthreads();
    }
}

__device__ __forceinline__ int moe_tables(Frame& F) {
    LAS int* pads = (LAS int*)(F.lds + MISC_PADS); LAS int* cnts = (LAS int*)(F.lds + MISC_CNTS); LAS int* blke = (LAS int*)(F.lds + MISC_BLKE);
    __syncthreads();
    if (F.tid < NE) cnts[F.tid] = (int)__hip_atomic_load(F.ctl + CW_CNT + F.tid * CW_CNT_STRIDE, __ATOMIC_RELAXED, __HIP_MEMORY_SCOPE_AGENT);
    __syncthreads();
    if (F.tid == 0) { int acc = 0;
        for (int e = 0; e < NE; ++e) { pads[e] = acc; acc += ((cnts[e] + 255) >> 8) << 8; }
        pads[NE] = acc; }
    __syncthreads();
    if (F.tid < NBLK_MAX) { const int s0 = F.tid << 8; int e = 0;
#pragma unroll 8
        for (int k = 1; k < NE; ++k) e += (pads[k] <= s0) ? 1 : 0;
        blke[F.tid] = e; }
    __syncthreads();
    return pads[NE] >> 8;
}

__device__ __forceinline__ void p9_gather(Frame& F) {
    constexpr int NUNIT = NTOK / 32;
    const int* ucnt = (const int*)(F.ws + WS_UCNT);
    LAS int* ubase = (LAS int*)(F.lds + RING_OFF);
    LAS int* segtot = (LAS int*)(F.lds + RING_OFF + NUNIT * NE * 4);
    LAS int* pads = (LAS int*)(F.lds + MISC_PADS); LAS int* cnts = (LAS int*)(F.lds + MISC_CNTS); LAS int* blke = (LAS int*)(F.lds + MISC_BLKE);
    __syncthreads();
    { const int e = F.tid & 31, seg = F.tid >> 5;
      int run = 0;
#pragma unroll 8
      for (int u = 0; u < 32; ++u) { const int un = seg * 32 + u; const int c = ucnt[un * NE + e]; ubase[un * NE + e] = run; run += c; }
      segtot[seg * NE + e] = run; }
    __syncthreads();
    if (F.tid < NE) { int run = 0;
        for (int seg = 0; seg < 16; ++seg) { const int c = segtot[seg * NE + F.tid]; segtot[seg * NE + F.tid] = run; run += c; }
        cnts[F.tid] = run;
        if (blockIdx.x == 0) F.ctl[CW_CNT + F.tid * CW_CNT_STRIDE] = (unsigned)run; }
    __syncthreads();
    if (F.tid == 0) { int acc = 0;
        for (int e = 0; e < NE; ++e) { pads[e] = acc; acc += ((cnts[e] + 255) >> 8) << 8; }
        pads[NE] = acc; }
    __syncthreads();
    if (F.tid < NBLK_MAX) { const int s0 = F.tid << 8; int e = 0;
#pragma unroll 8
        for (int k = 1; k < NE; ++k) e += (pads[k] <= s0) ? 1 : 0;
        blke[F.tid] = e; }
    const int* asg_e = (const int*)(F.ws + WS_ASG); const int* asg_r = asg_e + NASG; int* asg_s = (int*)(asg_r + 2 * NASG);
    int* stok = (int*)(F.ws + WS_STOK);
    for (int a = blockIdx.x * 512 + F.tid; a < NASG; a += F.G * 512) {
        const int e = asg_e[a], un = a >> 7, slot = pads[e] + segtot[(un >> 5) * NE + e] + ubase[un * NE + e] + asg_r[a];
        stok[slot] = a >> 2; asg_s[a] = slot;
    }
    for (int idx = blockIdx.x * 512 + F.tid; idx < NE * 256; idx += F.G * 512) {
        const int e = idx >> 8, r = idx & 255, c = cnts[e], padded = ((c + 255) >> 8) << 8;
        if (r < padded - c) stok[pads[e] + c + r] = 0;
    }
    __syncthreads();
}

#ifndef YS_FP8
#define YS_FP8 1
#endif
__device__ __forceinline__ void unpack8_fp8(const v2u w, float (&f)[8]) {
    const auto a = __builtin_amdgcn_cvt_pk_f32_fp8((int)w.x, false), b = __builtin_amdgcn_cvt_pk_f32_fp8((int)w.x, true), c = __builtin_amdgcn_cvt_pk_f32_fp8((int)w.y, false), d = __builtin_amdgcn_cvt_pk_f32_fp8((int)w.y, true);
    f[0] = a[0]; f[1] = a[1]; f[2] = b[0]; f[3] = b[1]; f[4] = c[0]; f[5] = c[1]; f[6] = d[0]; f[7] = d[1];
}
__device__ __forceinline__ void p12_combine(Frame& F, bool dummy = false) {
    const int* asg_s = (const int*)(F.ws + WS_ASG) + 3 * NASG; const float* asg_g = (const float*)(F.ws + WS_ASG) + 2 * NASG;
    float* out = F.out; float* dst = dummy ? (float*)(F.ws + WS_OD) : F.out;
    const int lane = F.lane;
    for (int t = F.gw; t < NTOK; t += F.NGW) {
        int sl[TOPK]; float g[TOPK];
#pragma unroll
        for (int k = 0; k < TOPK; ++k) { sl[k] = asg_s[t * TOPK + k]; g[k] = asg_g[t * TOPK + k]; }
        f32x4 a0[4], a1[4]; v4u xb[4];
#if YS_FP8
        const unsigned char* YS = F.ws + WS_YS; v2u y[4][TOPK];
#else
        const bf16* YS = (const bf16*)(F.ws + WS_YS); v4u y[4][TOPK];
#endif
#pragma unroll
        for (int j = 0; j < 4; ++j) { const int ch = lane + 64 * j;
#if X1_BF16
            xb[j] = *(const v4u*)((const bf16*)(F.ws + WS_XG) + (size_t)t * DM + ch * 8);
#else
            { const f32x4* o = (const f32x4*)(out + (size_t)t * DM + ch * 8); a0[j] = o[0]; a1[j] = o[1]; }
#endif
#pragma unroll
            for (int k = 0; k < TOPK; ++k) {
#if YS_FP8
                y[j][k] = *(const v2u*)(YS + (size_t)sl[k] * DM + ch * 8);
#else
                y[j][k] = *(const v4u*)(YS + (size_t)sl[k] * DM + ch * 8);
#endif
            } }
#pragma unroll
        for (int j = 0; j < 4; ++j) { const int ch = lane + 64 * j; f32x4* od = (f32x4*)(dst + (size_t)t * DM + ch * 8);
#if X1_BF16
            { float f[8]; unpack8(xb[j], f); a0[j] = (f32x4){f[0], f[1], f[2], f[3]}; a1[j] = (f32x4){f[4], f[5], f[6], f[7]}; }
#endif
#pragma unroll
            for (int k = 0; k < TOPK; ++k) { float f[8];
#if YS_FP8
                unpack8_fp8(y[j][k], f);
#else
                unpack8(y[j][k], f);
#endif
                a0[j].x += g[k] * f[0]; a0[j].y += g[k] * f[1]; a0[j].z += g[k] * f[2]; a0[j].w += g[k] * f[3]; a1[j].x += g[k] * f[4]; a1[j].y += g[k] * f[5]; a1[j].z += g[k] * f[6]; a1[j].w += g[k] * f[7]; }
            od[0] = a0[j]; od[1] = a1[j]; }
    }
}

#ifndef MK_SINGLE
#define MK_SINGLE 1
#endif
constexpr int N_PHASES = 13;

__global__ void __launch_bounds__(NWAVES * 64, 2) mk_fwd(Args args) {
    extern __shared__ __attribute__((aligned(16))) unsigned char lds_raw[];
    Frame F;
    F.lds = (LAS unsigned char*)lds_raw;
    F.tid = threadIdx.x; F.lane = F.tid & 63; F.wave = __builtin_amdgcn_readfirstlane(F.tid >> 6);
    F.G = gridDim.x; F.gw = blockIdx.x * NWAVES + F.wave; F.NGW = F.G * NWAVES;
    F.in = args.in; F.out = args.out; F.ws = args.ws; F.ctl = (unsigned*)(args.ws + WS_CTL);
    const int lo = args.ph_lo, hi = args.ph_hi;
    for (int u = F.tid; u < (LDS_BYTES - MISC_OFF) / 4; u += NWAVES * 64) ((LAS unsigned*)(F.lds + MISC_OFF))[u] = 0u;
    __syncthreads();
    XcdBarrier bar; bar.bar = F.ctl + CW_BAR; bar.x = 0; bar.st = nullptr;
    if (hi - lo > 1) bar = xcd_barrier_post(F.ctl + CW_BAR, (volatile LAS unsigned*)(F.lds + MISC_BAR));
#ifndef PHASE_MASK
#define PHASE_MASK 0x1FFF
#endif
#define IN(k) (((PHASE_MASK >> (k)) & 1) && lo <= (k) && (k) < hi)
#define SEAM(k) do { if (IN(k) && IN((k) + 1)) xcd_barrier(bar); } while (0)
#ifndef REPEAT_MASK
#define REPEAT_MASK 0
#endif
#define REP(k) (((REPEAT_MASK >> (k)) & 1) ? 2 : 1)

    if (IN(0)) { _Pragma("unroll") for (int rep = 0; rep < REP(0); ++rep) { if (rep) xcd_barrier(bar); p0_prologue(F); } } SEAM(0);

    if (IN(1)) { _Pragma("unroll") for (int rep = 0; rep < REP(1); ++rep) { if (rep) xcd_barrier(bar);
        pg8::Gemm g{F.ws + WS_H, F.ws + WS_WIN, DM * (INPROJ_FP8 ? 1 : 2), 0, nullptr, nullptr};
        pg8::StaticOrder S; S.init(NTOK, INWP, F.G, (int)blockIdx.x);
        pg8::EpiBf16 E{(bf16*)(F.ws + WS_PROJ), INWP, nullptr, 0, INPROJ_FP8 ? WSCALE_INV : 1.0f};
        pg8::gemm_phase<pg8::EpiBf16, pg8::StaticOrder, true, true, INPROJ_FP8 != 0>(F.lds + RING_OFF, g, S, E);
    } } SEAM(1);

    if (IN(2)) { _Pragma("unroll") for (int rep = 0; rep < REP(2); ++rep) { if (rep) xcd_barrier(bar); p2_prep1(F); } } SEAM(2);

    if (IN(3)) { _Pragma("unroll") for (int rep = 0; rep < REP(3); ++rep) { if (rep) xcd_barrier(bar);
        { pg8::Gemm g{F.ws + WS_AQ, F.ws + WS_WUQ, QRANK * 2, 0, nullptr, nullptr};
          pg8::StaticOrder S; S.init(NTOK, MH * QKD, F.G, (int)blockIdx.x);
          pg8::EpiBf16 E{(bf16*)(F.ws + WS_QF), MH * QKD, nullptr, 0, 1.0f};
          pg8::gemm_phase<pg8::EpiBf16, pg8::StaticOrder, true, true>(F.lds + RING_OFF, g, S, E); }
        { pg8::Gemm g{F.ws + WS_AKV, F.ws + WS_WUKV, KVRANK * 2, 0, nullptr, nullptr};
          pg8::StaticOrder S; S.init(NTOK, MH * 256, F.G, (int)blockIdx.x);
          pg8::EpiKV E{(bf16*)(F.ws + WS_KVF), (bf16*)(F.ws + WS_KM), F.in[8], (const float*)(F.ws + WS_DQN), (const bf16*)(F.ws + WS_PROJ), (LAS float*)(F.lds + MISC_OFF + 8192)};
          pg8::gemm_phase<pg8::EpiKV, pg8::StaticOrder, true, true>(F.lds + RING_OFF, g, S, E); }
    } }
    if (IN(3) && IN(5)) xcd_barrier(bar);

    if (IN(5)) { _Pragma("unroll") for (int rep = 0; rep < REP(5); ++rep) { if (rep) xcd_barrier(bar); p5_attention(F, rep); } }
    if (IN(5) && IN(7)) xcd_barrier(bar);

    if (IN(7)) { _Pragma("unroll") for (int rep = 0; rep < REP(7); ++rep) { if (rep) xcd_barrier(bar);
        pg8::Gemm g{F.ws + WS_Y, F.ws + WS_WO, DM * 2, 0, nullptr, nullptr};
        pg8::StaticOrder S; S.init(NTOK, DM, F.G, (int)blockIdx.x);
#if X1_BF16
        pg8::EpiResBf16 E{F.in[0], (bf16*)(F.ws + WS_XG), DM};
        pg8::gemm_phase<pg8::EpiResBf16, pg8::StaticOrder, true, true>(F.lds + RING_OFF, g, S, E);
#else
        pg8::EpiResF32 E{F.in[0], F.out, DM, X1_COPY ? (bf16*)(F.ws + WS_XG) : nullptr};
        pg8::gemm_phase<pg8::EpiResF32, pg8::StaticOrder, true, true>(F.lds + RING_OFF, g, S, E);
#endif
    } } SEAM(7);

    if (IN(8)) { _Pragma("unroll") for (int rep = 0; rep < REP(8); ++rep) { if (rep) xcd_barrier(bar); p8_router(F, rep); } } SEAM(8);

    if (IN(9)) { _Pragma("unroll") for (int rep = 0; rep < REP(9); ++rep) { if (rep) xcd_barrier(bar); p9_gather(F); } } SEAM(9);

    if (IN(10)) { _Pragma("unroll") for (int rep = 0; rep < REP(10); ++rep) { if (rep) xcd_barrier(bar);
        const int nblk = moe_tables(F);
        pg8::Gemm g{F.ws + WS_H2, F.ws + WS_WGU, DM, (size_t)2 * DFF * DM, (const int*)(F.ws + WS_STOK), (LAS int*)(F.lds + MISC_ITAB)};
        pg8::MoeOrder S; S.init(nblk, 2 * DFF, F.G, (int)blockIdx.x, (const LAS int*)(F.lds + MISC_BLKE), (const LAS int*)(F.lds + MISC_PADS));
        pg8::EpiGU E{F.ws + WS_ACT, DFF, F.in[21], 2 * DFF, WSCALE_INV};
        pg8::gemm_phase<pg8::EpiGU, pg8::MoeOrder, true, true, true, true>(F.lds + RING_OFF, g, S, E);
    } } SEAM(10);

    if (IN(11)) { _Pragma("unroll") for (int rep = 0; rep < REP(11); ++rep) { if (rep) xcd_barrier(bar);
        const int nblk = moe_tables(F);
        pg8::Gemm g{F.ws + WS_ACT, F.ws + WS_WDN, DFF, (size_t)DM * DFF, nullptr, nullptr};
        pg8::MoeOrder S; S.init(nblk, DM, F.G, (int)blockIdx.x, (const LAS int*)(F.lds + MISC_BLKE), (const LAS int*)(F.lds + MISC_PADS));
#if YS_FP8
        pg8::EpiFp8 E{F.ws + WS_YS, DM, F.in[23], DM, WSCALE_INV};
        pg8::gemm_phase<pg8::EpiFp8, pg8::MoeOrder, true, true, true>(F.lds + RING_OFF, g, S, E);
#else
        pg8::EpiBf16 E{(bf16*)(F.ws + WS_YS), DM, F.in[23], DM, WSCALE_INV};
        pg8::gemm_phase<pg8::EpiBf16, pg8::MoeOrder, true, true, true>(F.lds + RING_OFF, g, S, E);
#endif
    } } SEAM(11);

    if (IN(12)) { _Pragma("unroll") for (int rep = 0; rep < REP(12); ++rep) { if (rep) xcd_barrier(bar); p12_combine(F, rep + 1 < REP(12)); } }
#undef IN
#undef SEAM
}

extern "C" void kernel_launch(void* const* d_in, const int* in_sizes, int n_in, void* d_out, int out_size, void* d_ws, size_t ws_size, hipStream_t stream) {
    static int grid = 0;
    if (grid == 0) {
        if (n_in != 25 || out_size != NTOK * DM || ws_size < WS_END) { fprintf(stderr, "kernel_launch: unexpected shapes: n_in %d out %d ws %zu (need %zu)\n", n_in, out_size, ws_size, (size_t)WS_END); grid = -1; return; }
        int dev = 0, cus = 0, per_cu = 0;
        if (hipGetDevice(&dev) != hipSuccess || hipDeviceGetAttribute(&cus, hipDeviceAttributeMultiprocessorCount, dev) != hipSuccess) { grid = -1; return; }
        if (hipFuncSetAttribute((const void*)mk_fwd, hipFuncAttributeMaxDynamicSharedMemorySize, LDS_BYTES) != hipSuccess) { fprintf(stderr, "kernel_launch: hipFuncSetAttribute failed\n"); grid = -1; return; }
        if (hipOccupancyMaxActiveBlocksPerMultiprocessor(&per_cu, (const void*)mk_fwd, NWAVES * 64, LDS_BYTES) != hipSuccess || per_cu < 1) { fprintf(stderr, "kernel_launch: occupancy query says %d\n", per_cu); }
        (void)hipGetLastError();
        grid = cus;
    }
    if (grid < 0) return;
    if (hipMemsetAsync((char*)d_ws + WS_CTL, 0, CTL_ZERO_BYTES, stream) != hipSuccess) return;
    Args a{};
    for (int i = 0; i < 25; ++i) a.in[i] = (const float*)d_in[i];
    a.out = (float*)d_out; a.ws = (unsigned char*)d_ws;
#if MK_SINGLE
    a.ph_lo = 0; a.ph_hi = N_PHASES;
    hipLaunchKernelGGL(mk_fwd, dim3(grid), dim3(NWAVES * 64), LDS_BYTES, stream, a);
#else
    for (int p = 0; p < N_PHASES; ++p) { a.ph_lo = p; a.ph_hi = p + 1; hipLaunchKernelGGL(mk_fwd, dim3(grid), dim3(NWAVES * 64), LDS_BYTES, stream, a); }
#endif
    const hipError_t le = hipPeekAtLastError();
    if (le != hipSuccess) fprintf(stderr, "kernel_launch: launch failed: %s\n", hipGetErrorName(le));
}
```
